# Optimizing an MI355X kernel written in HIP

```python
import math
import jax, jax.numpy as jnp
from jax import lax
import numpy as np

D_MODEL = 2048
BATCH = 2
SEQ = 4096
DEPTH = 4

GLA_HEADS = 4
GLA_KEY_DIM = D_MODEL // 2
GLA_VAL_DIM = D_MODEL
GLA_HEAD_K = GLA_KEY_DIM // GLA_HEADS
GLA_HEAD_V = GLA_VAL_DIM // GLA_HEADS
GK_RANK = 16
GATE_LOGIT_NORMALIZER = 16.0
GLA_CHUNK = 64

DIFF_HEAD_DIM = 64
DIFF_HEADS = D_MODEL // (2 * DIFF_HEAD_DIM)
DIFF_QK_DIM = DIFF_HEADS * 2 * DIFF_HEAD_DIM
DIFF_VAL_DIM = DIFF_HEADS * 2 * DIFF_HEAD_DIM
Q_BLOCK = 128

SPLIT_SIZES = (
    GLA_KEY_DIM,
    GLA_KEY_DIM,
    GLA_VAL_DIM,
    GLA_VAL_DIM,
    GK_RANK,
    DIFF_QK_DIM,
    DIFF_QK_DIM,
    DIFF_VAL_DIM,
    DIFF_VAL_DIM,
    D_MODEL,
    D_MODEL,
)
N_IN = 4 * GLA_KEY_DIM // 2 + 2 * GLA_VAL_DIM + GK_RANK + 2 * DIFF_QK_DIM + 2 * DIFF_VAL_DIM + 2 * D_MODEL
EPS = 1e-6

kernel_name = "gla_diffattn_gated_hybrid"


def rmsnorm(x, g):
    xf = x.astype(jnp.float32)
    y = xf * lax.rsqrt(jnp.mean(xf * xf, axis=-1, keepdims=True) + EPS) * g.astype(jnp.float32)
    return y.astype(x.dtype)


def gla_chunked(q, k, v, gk):
    B, S, H, dk = q.shape
    dv = v.shape[-1]
    n = S // GLA_CHUNK

    def to_chunks(t):
        return t.reshape(B, n, GLA_CHUNK, H, t.shape[-1]).transpose(1, 0, 3, 2, 4)

    qc, kc, vc, gc = to_chunks(q * (dk ** -0.5)), to_chunks(k), to_chunks(v), to_chunks(gk)
    causal = jnp.tril(jnp.ones((GLA_CHUNK, GLA_CHUNK), dtype=bool))

    def step(state, inp):
        qi, ki, vi, gi = inp
        b = jnp.cumsum(gi, axis=-2)
        o_inter = jnp.einsum('bhtk,bhkv->bhtv', qi * jnp.exp(b), state)
        rel = b[:, :, :, None, :] - b[:, :, None, :, :]
        decay = jnp.exp(jnp.where(causal[:, :, None], rel, -jnp.inf))
        scores = jnp.einsum('bhtk,bhsk,bhtsk->bhts', qi, ki, decay)
        o = o_inter + jnp.einsum('bhts,bhsv->bhtv', scores, vi)
        b_last = b[:, :, -1:, :]
        state = jnp.exp(b_last[:, :, 0, :])[..., None] * state + jnp.einsum(
            'bhck,bhcv->bhkv', ki * jnp.exp(b_last - b), vi)
        return state, o

    state0 = jnp.zeros((B, H, dk, dv), jnp.float32)
    _, o = lax.scan(step, state0, (qc, kc, vc, gc))
    return o.transpose(1, 0, 3, 2, 4).reshape(B, S, H, dv)


def diff_attention(q, k, v, lam):
    B, S, H, _, d = q.shape
    nb = S // Q_BLOCK
    qb = (q * (d ** -0.5)).reshape(B, nb, Q_BLOCK, H, 2, d).transpose(1, 0, 2, 3, 4, 5)
    kpos = jnp.arange(S)

    def block(args):
        qi, i = args
        s = jnp.einsum('bqhmd,bkhmd->bhmqk', qi, k).astype(jnp.float32)
        qpos = i * Q_BLOCK + jnp.arange(Q_BLOCK)
        mask = kpos[None, :] <= qpos[:, None]
        p = jax.nn.softmax(jnp.where(mask, s, -jnp.inf), axis=-1)
        w = p[:, :, 0] - lam * p[:, :, 1]
        return jnp.einsum('bhqk,bkhv->bqhv', w.astype(v.dtype), v)

    o = lax.map(block, (qb, jnp.arange(nb)))
    return o.transpose(1, 0, 2, 3, 4).reshape(B, S, H, 2 * d)


def setup_inputs(seed: int = 0) -> dict:
    key = jax.random.key(seed)
    ks = jax.random.split(key, 13)
    f32 = jnp.float32
    x = jax.random.normal(ks[0], (BATCH, SEQ, D_MODEL), f32)
    pre_norm_g = 1.0 + 0.02 * jax.random.normal(ks[1], (DEPTH, D_MODEL), f32)
    post_norm_g = 1.0 + 0.02 * jax.random.normal(ks[2], (DEPTH, D_MODEL), f32)
    w_in = jax.random.normal(ks[3], (DEPTH, D_MODEL, N_IN), f32) * D_MODEL ** -0.5
    gla_gk_w2 = jax.random.normal(ks[4], (DEPTH, GK_RANK, GLA_KEY_DIM), f32) * GK_RANK ** -0.5
    gla_gk_b = 0.1 * jax.random.normal(ks[5], (DEPTH, GLA_KEY_DIM), f32)
    gla_norm_g = 1.0 + 0.02 * jax.random.normal(ks[6], (DEPTH, GLA_HEAD_V), f32)
    diff_lambda = 0.1 * jax.random.normal(ks[7], (DEPTH, 4, DIFF_HEAD_DIM), f32)
    diff_norm_g = 1.0 + 0.02 * jax.random.normal(ks[8], (DEPTH, 2 * DIFF_HEAD_DIM), f32)
    w_branch_a = jax.random.normal(ks[9], (DEPTH, GLA_VAL_DIM, D_MODEL), f32) * GLA_VAL_DIM ** -0.5
    w_branch_b = jax.random.normal(ks[10], (DEPTH, DIFF_VAL_DIM, D_MODEL), f32) * DIFF_VAL_DIM ** -0.5
    w_out = jax.random.normal(ks[11], (DEPTH, D_MODEL, D_MODEL), f32) * D_MODEL ** -0.5
    return {"x": x, "pre_norm_g": pre_norm_g, "post_norm_g": post_norm_g, "w_in": w_in,
            "gla_gk_w2": gla_gk_w2, "gla_gk_b": gla_gk_b, "gla_norm_g": gla_norm_g,
            "diff_lambda": diff_lambda, "diff_norm_g": diff_norm_g,
            "w_branch_a": w_branch_a, "w_branch_b": w_branch_b, "w_out": w_out}


def reference(x, pre_norm_g, post_norm_g, w_in, gla_gk_w2, gla_gk_b, gla_norm_g,
              diff_lambda, diff_norm_g, w_branch_a, w_branch_b, w_out):
    B, S, _ = x.shape
    offsets = list(np.cumsum(SPLIT_SIZES)[:-1])
    for l in range(DEPTH):
        h = rmsnorm(x, pre_norm_g[l])
        proj = h @ w_in[l]
        (a_q, a_k, a_v, a_g, a_lr, b_q, b_k, b_v, b_g, m_a, m_b) = jnp.split(proj, offsets, axis=-1)

        gk = jax.nn.log_sigmoid((a_lr @ gla_gk_w2[l] + gla_gk_b[l]).astype(jnp.float32)) / GATE_LOGIT_NORMALIZER
        o_a = gla_chunked(
            a_q.astype(jnp.float32).reshape(B, S, GLA_HEADS, GLA_HEAD_K),
            a_k.astype(jnp.float32).reshape(B, S, GLA_HEADS, GLA_HEAD_K),
            a_v.astype(jnp.float32).reshape(B, S, GLA_HEADS, GLA_HEAD_V),
            gk.reshape(B, S, GLA_HEADS, GLA_HEAD_K)).astype(h.dtype)
        o_a = rmsnorm(o_a, gla_norm_g[l]).reshape(B, S, GLA_VAL_DIM) * jax.nn.silu(a_g)
        y_a = o_a @ w_branch_a[l]

        lam_init = 0.8 - 0.6 * math.exp(-0.3 * l)
        lq1, lk1, lq2, lk2 = [diff_lambda[l, i].astype(jnp.float32) for i in range(4)]
        lam = jnp.exp(jnp.sum(lq1 * lk1)) - jnp.exp(jnp.sum(lq2 * lk2)) + lam_init
        o_b = diff_attention(
            b_q.reshape(B, S, DIFF_HEADS, 2, DIFF_HEAD_DIM),
            b_k.reshape(B, S, DIFF_HEADS, 2, DIFF_HEAD_DIM),
            b_v.reshape(B, S, DIFF_HEADS, 2 * DIFF_HEAD_DIM), lam)
        o_b = rmsnorm(o_b, diff_norm_g[l]) * (1.0 - lam_init)
        o_b = o_b.reshape(B, S, DIFF_VAL_DIM) * jax.nn.silu(b_g)
        y_b = o_b @ w_branch_b[l]

        merged = jax.nn.sigmoid(m_a) * y_a + jax.nn.sigmoid(m_b) * y_b
        out = merged @ w_out[l]
        x = x + rmsnorm(out, post_norm_g[l])
    return x
```

```cpp
#include <hip/hip_runtime.h>
#include <hip/hip_cooperative_groups.h>
#include <cstdio>
#include <cstdint>
namespace pg8 {
#define PG8_LAS __attribute__((address_space(3)))
typedef unsigned short bf16_t;
typedef short bf16x8 __attribute__((ext_vector_type(8)));
typedef float f32x4 __attribute__((ext_vector_type(4)));
typedef unsigned u32x4 __attribute__((ext_vector_type(4)));
constexpr int BM = 256, BK = 64, HALF = 128, HTB = HALF * BK * 2  , STAGE_BYTES = 8 * HTB, NXCD = 8, WGM = 8;

__host__ __device__ __forceinline__ int lds_byte(int r, int c) { const int st = (r >> 4) * 2 + (c >> 5), rr = r & 15, cc = c & 31, ob = rr * 64 + cc * 2; return st * 1024 + (ob ^ (((ob >> 9) & 1) << 5)); }
__host__ __device__ __forceinline__ void stage_rc(int b, int& R, int& C) { const int st = b / 1024, sb = b % 1024, swz = sb ^ (((sb >> 9) & 1) << 5); R = (st >> 1) * 16 + swz / 64; C = (st & 1) * 32 + (swz % 64) / 2; }
__host__ __device__ __forceinline__ int perm32(int rho) { const int n = rho >> 4, i = rho & 15; return 8 * (i >> 2) + 4 * n + (i & 3); }

struct Unit { int pm, pn; };
struct Gemm { const bf16_t* A; const bf16_t* Bt; int M, N, K; };

struct StaticOrder {
    int nM, nN, nwg, G, c;
    __host__ __device__ void init(int M, int N, int G_, int c_) { nM = M / BM; nN = N / BM; nwg = nM * nN; G = G_; c = c_; }
    __host__ __device__ bool next(int i, Unit& u) const {
        const long L = (long)i * G + c; if (L >= nwg) return false;
        int wgid = (int)L; { const int q = nwg / NXCD, r = nwg % NXCD, xcd = wgid % NXCD, off = wgid / NXCD; wgid = (xcd < r ? xcd * (q + 1) : r * (q + 1) + (xcd - r) * q) + off; }
        const int nig = WGM * nN, gid = wgid / nig, fm = gid * WGM, gsz = (nM - fm) < WGM ? (nM - fm) : WGM;
        u.pm = fm + ((wgid % nig) % gsz); u.pn = (wgid % nig) / gsz; return true;
    }
    __device__ __forceinline__ void a_ready(const Unit&) const {}
    __device__ __forceinline__ void done(const Unit&) const {}
};

__device__ __forceinline__ unsigned cvt_pk_bf16(float lo, float hi) { unsigned r; asm volatile("v_cvt_pk_bf16_f32 %0, %1, %2" : "=v"(r) : "v"(lo), "v"(hi)); return r; }
constexpr int NP = 18432;
constexpr float QC2 = 0.125f * 1.4426950408889634f;
__device__ __forceinline__ float bflo(unsigned w) { return __uint_as_float(w << 16); }
__device__ __forceinline__ float bfhi(unsigned w) { return __uint_as_float(w & 0xffff0000u); }
__device__ __forceinline__ float sigm(float x) { return __builtin_amdgcn_rcpf(1.0f + __builtin_amdgcn_exp2f(-1.4426950408889634f * x)); }
struct EpiProj {
    static constexpr bool PERM = true, AFTER_DRAIN = false;
    bf16_t* O;
    __device__ __forceinline__ void operator()(const f32x4 (&acc)[2][2][4][2], const Unit& u, int wr, int wc, int fr, int fq) const {
        const int row0 = u.pm * BM + wr * 64 + fr; const int colt = u.pn * BM;
        float sc = 1.f; if (colt < 1024) sc = 0.0625f; else if (colt >= 6144 && colt < 8192) sc = QC2;
        const int col0 = colt + wc * 32 + 8 * fq;
#pragma unroll
        for (int ai = 0; ai < 2; ++ai)
#pragma unroll
            for (int m = 0; m < 4; ++m) { bf16_t* rowp = O + (size_t)(row0 + ai * HALF + m * 16) * NP + col0;
#pragma unroll
                for (int bj = 0; bj < 2; ++bj) { const f32x4 v0 = acc[ai][bj][m][0] * sc, v1 = acc[ai][bj][m][1] * sc;
                    u32x4 w; w.x = cvt_pk_bf16(v0[0], v0[1]); w.y = cvt_pk_bf16(v0[2], v0[3]); w.z = cvt_pk_bf16(v1[0], v1[1]); w.w = cvt_pk_bf16(v1[2], v1[3]);
                    *(u32x4*)(rowp + bj * HALF) = w; } }
    }
};
struct EpiGateA {
    static constexpr bool PERM = true, AFTER_DRAIN = false;
    const bf16_t* P; float* T1;
    __device__ __forceinline__ void operator()(const f32x4 (&acc)[2][2][4][2], const Unit& u, int wr, int wc, int fr, int fq) const {
        const int row0 = u.pm * BM + wr * 64 + fr; const int col0 = u.pn * BM + wc * 32 + 8 * fq;
#pragma unroll
        for (int ai = 0; ai < 2; ++ai)
#pragma unroll
            for (int m = 0; m < 4; ++m) { const size_t row = (size_t)(row0 + ai * HALF + m * 16);
#pragma unroll
                for (int bj = 0; bj < 2; ++bj) { const int col = col0 + bj * HALF;
                    const u32x4 g = *(const u32x4*)(P + row * NP + 14336 + col);
                    f32x4 o0, o1; const f32x4 a0 = acc[ai][bj][m][0], a1 = acc[ai][bj][m][1];
                    o0[0] = a0[0] * sigm(bflo(g.x)); o0[1] = a0[1] * sigm(bfhi(g.x)); o0[2] = a0[2] * sigm(bflo(g.y)); o0[3] = a0[3] * sigm(bfhi(g.y));
                    o1[0] = a1[0] * sigm(bflo(g.z)); o1[1] = a1[1] * sigm(bfhi(g.z)); o1[2] = a1[2] * sigm(bflo(g.w)); o1[3] = a1[3] * sigm(bfhi(g.w));
                    float* tp = T1 + row * 2048 + col; *(f32x4*)tp = o0; *(f32x4*)(tp + 4) = o1; } }
    }
};
struct EpiGateB {
    static constexpr bool PERM = true, AFTER_DRAIN = false;
    const bf16_t* P; const float* T1; bf16_t* MG;
    __device__ __forceinline__ void operator()(const f32x4 (&acc)[2][2][4][2], const Unit& u, int wr, int wc, int fr, int fq) const {
        const int row0 = u.pm * BM + wr * 64 + fr; const int col0 = u.pn * BM + wc * 32 + 8 * fq;
#pragma unroll
        for (int ai = 0; ai < 2; ++ai)
#pragma unroll
            for (int m = 0; m < 4; ++m) { const size_t row = (size_t)(row0 + ai * HALF + m * 16);
#pragma unroll
                for (int bj = 0; bj < 2; ++bj) { const int col = col0 + bj * HALF;
                    const u32x4 g = *(const u32x4*)(P + row * NP + 16384 + col);
                    const float* tp = T1 + row * 2048 + col; const f32x4 t0 = *(const f32x4*)tp, t1 = *(const f32x4*)(tp + 4);
                    f32x4 o0, o1; const f32x4 a0 = acc[ai][bj][m][0], a1 = acc[ai][bj][m][1];
                    o0[0] = t0[0] + a0[0] * sigm(bflo(g.x)); o0[1] = t0[1] + a0[1] * sigm(bfhi(g.x)); o0[2] = t0[2] + a0[2] * sigm(bflo(g.y)); o0[3] = t0[3] + a0[3] * sigm(bfhi(g.y));
                    o1[0] = t1[0] + a1[0] * sigm(bflo(g.z)); o1[1] = t1[1] + a1[1] * sigm(bfhi(g.z)); o1[2] = t1[2] + a1[2] * sigm(bflo(g.w)); o1[3] = t1[3] + a1[3] * sigm(bfhi(g.w));
                    u32x4 w; w.x = cvt_pk_bf16(o0[0], o0[1]); w.y = cvt_pk_bf16(o0[2], o0[3]); w.z = cvt_pk_bf16(o1[0], o1[1]); w.w = cvt_pk_bf16(o1[2], o1[3]);
                    *(u32x4*)(MG + row * 2048 + col) = w; } }
    }
};
struct EpiOut {
    static constexpr bool PERM = true, AFTER_DRAIN = false;
    float* OUT; float* PS;
    __device__ __forceinline__ void operator()(const f32x4 (&acc)[2][2][4][2], const Unit& u, int wr, int wc, int fr, int fq) const {
        const int row0 = u.pm * BM + wr * 64 + fr; const int col0 = u.pn * BM + wc * 32 + 8 * fq;
#pragma unroll
        for (int ai = 0; ai < 2; ++ai)
#pragma unroll
            for (int m = 0; m < 4; ++m) { const size_t row = (size_t)(row0 + ai * HALF + m * 16); float s = 0.f;
#pragma unroll
                for (int bj = 0; bj < 2; ++bj) { const f32x4 a0 = acc[ai][bj][m][0], a1 = acc[ai][bj][m][1];
                    float* op = OUT + row * 2048 + col0 + bj * HALF; *(f32x4*)op = a0; *(f32x4*)(op + 4) = a1;
                    s += (a0[0] * a0[0] + a0[1] * a0[1]) + (a0[2] * a0[2] + a0[3] * a0[3]) + (a1[0] * a1[0] + a1[1] * a1[1]) + (a1[2] * a1[2] + a1[3] * a1[3]); }
                s += __uint_as_float(__builtin_amdgcn_ds_bpermute((((fq ^ 1) << 4) | fr) << 2, __float_as_uint(s))); s += __uint_as_float(__builtin_amdgcn_ds_bpermute((((fq ^ 2) << 4) | fr) << 2, __float_as_uint(s)));
                if (fq == 0) PS[row * 32 + u.pn * 4 + wc] = s; }
    }
};
template <class Epi, class Sched, bool ALIGN_EPI = false, bool SP2 = false>
__device__ __forceinline__ void gemm_phase(PG8_LAS unsigned char* lds, const Gemm g, const Sched& S, const Epi& E, const int tid) {
    const int wid = __builtin_amdgcn_readfirstlane(tid >> 6), lane = tid & 63, wr = wid >> 2, wc = wid & 3, fr = lane & 15, fq = lane >> 4;
    const int K = g.K, nt = K / BK;
    unsigned voffA[2], voffB[2];
#pragma unroll
    for (int i = 0; i < 2; ++i) { int R, C; stage_rc(tid * 16 + i * 8192, R, C); const int Rb = Epi::PERM ? ((R & ~31) + perm32(R & 31)) : R;
        voffA[i] = (unsigned)(R * K + C) * 2u; voffB[i] = (unsigned)(Rb * K + C) * 2u; }
    const size_t kstep = (size_t)(BK * 2);
    const size_t hstep = (size_t)HALF * K * 2;
    const size_t tstep = 2 * hstep;
    const unsigned ldsw = (unsigned)wid * 1024u;
    const int aoff = lds_byte(wr * 64 + fr, fq * 8), boff = lds_byte(wc * 32 + fr, fq * 8);
#define PG8_SA(b, h) (((b) * 2 + (h)) * HTB)
#define PG8_SB(b, h) ((4 + (b) * 2 + (h)) * HTB)
#define PG8_STAGE(bufoff, gbase, voff) do { _Pragma("unroll") for (int _i = 0; _i < 2; ++_i) \
        __builtin_amdgcn_global_load_lds((const unsigned*)((const char*)(gbase) + (voff)[_i]), (PG8_LAS unsigned*)(lds + (bufoff) + ldsw + _i * 8192), 16, 0, 0); } while (0)
#define PG8_LDA(dst, b, h) do { _Pragma("unroll") for (int m = 0; m < 4; ++m) _Pragma("unroll") for (int k = 0; k < 2; ++k) dst[m][k] = *(const PG8_LAS bf16x8*)(lds + PG8_SA(b, h) + aoff + m * 2048 + k * 1024); } while (0)
#define PG8_LDB(dst, b, h) do { _Pragma("unroll") for (int n = 0; n < 2; ++n) _Pragma("unroll") for (int k = 0; k < 2; ++k) dst[n][k] = *(const PG8_LAS bf16x8*)(lds + PG8_SB(b, h) + boff + n * 2048 + k * 1024); } while (0)
#define PG8_MMA(ai, bj, At, Bt) do { __builtin_amdgcn_s_setprio(1); _Pragma("unroll") for (int m = 0; m < 4; ++m) _Pragma("unroll") for (int n = 0; n < 2; ++n) _Pragma("unroll") for (int k = 0; k < 2; ++k) \
        acc[ai][bj][m][n] = __builtin_amdgcn_mfma_f32_16x16x32_bf16(Bt[n][k], At[m][k], acc[ai][bj][m][n], 0, 0, 0); __builtin_amdgcn_s_setprio(0); } while (0)
#define PG8_WAIT_V(n) asm volatile("s_waitcnt vmcnt(" #n ")" ::: "memory")
#define PG8_WAIT_L(n) asm volatile("s_waitcnt lgkmcnt(" #n ")" ::: "memory")
#define PG8_BAR __builtin_amdgcn_s_barrier()
#define PG8_SCHED __builtin_amdgcn_sched_barrier(0)
    Unit cur, nxt; int ui = 0;
    if (!S.next(0, cur)) return;
    f32x4 acc[2][2][4][2];
#pragma unroll
    for (int a = 0; a < 2; ++a)
#pragma unroll
        for (int b = 0; b < 2; ++b)
#pragma unroll
            for (int m = 0; m < 4; ++m)
#pragma unroll
                for (int n = 0; n < 2; ++n) acc[a][b][m][n] = (f32x4){0.f, 0.f, 0.f, 0.f};
    bf16x8 At[4][2], B0[2][2], B1[2][2];
    const char* cA = (const char*)g.A + (size_t)cur.pm * tstep; const char* cB = (const char*)g.Bt + (size_t)cur.pn * tstep;
    S.a_ready(cur);
    if constexpr (SP2) {
        PG8_STAGE(PG8_SB(0, 0), cB, voffB); PG8_STAGE(PG8_SB(0, 1), cB + hstep, voffB); PG8_STAGE(PG8_SA(0, 0), cA, voffA); PG8_STAGE(PG8_SA(0, 1), cA + hstep, voffA);
        if (wr == 1) PG8_BAR;
        PG8_WAIT_V(2); PG8_BAR;
        PG8_STAGE(PG8_SB(1, 0), cB + kstep, voffB); PG8_STAGE(PG8_SA(1, 0), cA + kstep, voffA); PG8_STAGE(PG8_SB(1, 1), cB + hstep + kstep, voffB);
        PG8_WAIT_V(6); PG8_BAR;
    } else {
        PG8_STAGE(PG8_SB(0, 0), cB, voffB); PG8_STAGE(PG8_SA(0, 0), cA, voffA); PG8_STAGE(PG8_SB(0, 1), cB + hstep, voffB); PG8_STAGE(PG8_SA(0, 1), cA + hstep, voffA);
        if (wr == 1) PG8_BAR;
        PG8_WAIT_V(4); PG8_BAR;
        PG8_STAGE(PG8_SB(1, 0), cB + kstep, voffB); PG8_STAGE(PG8_SA(1, 0), cA + kstep, voffA); PG8_STAGE(PG8_SB(1, 1), cB + hstep + kstep, voffB);
        PG8_WAIT_V(6); PG8_BAR;
    }
    for (;;) {
        const bool has_next = S.next(ui + 1, nxt);
        const char* nA = has_next ? (const char*)g.A + (size_t)nxt.pm * tstep : cA; const char* nB = has_next ? (const char*)g.Bt + (size_t)nxt.pn * tstep : cB;
        for (int t = 0; t < nt; t += 2) {
            const bool last = (t == nt - 2);
            const char* a1 = cA + (size_t)(t + 1) * kstep;
            const char* a2 = last ? nA : cA + (size_t)(t + 2) * kstep; const char* b2 = last ? nB : cB + (size_t)(t + 2) * kstep;
            const char* a3 = a2 + kstep; const char* b3 = b2 + kstep;
            if (last && has_next) S.a_ready(nxt);
            if constexpr (SP2) {
            PG8_LDB(B0, 0, 0); PG8_LDB(B1, 0, 1); PG8_SCHED; PG8_LDA(At, 0, 0); PG8_STAGE(PG8_SA(1, 1), a1 + hstep, voffA);
            PG8_WAIT_V(8); PG8_WAIT_L(0); PG8_BAR; PG8_MMA(0, 0, At, B0); PG8_MMA(0, 1, At, B1); PG8_BAR; PG8_SCHED;
            PG8_LDA(At, 0, 1); PG8_STAGE(PG8_SB(0, 0), b2, voffB); PG8_STAGE(PG8_SB(0, 1), b2 + hstep, voffB); PG8_STAGE(PG8_SA(0, 0), a2, voffA);
            PG8_WAIT_V(8); PG8_WAIT_L(0); PG8_BAR; PG8_MMA(1, 0, At, B0); PG8_MMA(1, 1, At, B1); PG8_BAR; PG8_SCHED;
            PG8_LDB(B0, 1, 0); PG8_LDB(B1, 1, 1); PG8_SCHED; PG8_LDA(At, 1, 0); PG8_STAGE(PG8_SA(0, 1), a2 + hstep, voffA);
            PG8_WAIT_V(8); PG8_WAIT_L(0); PG8_BAR; PG8_MMA(0, 0, At, B0); PG8_MMA(0, 1, At, B1); PG8_BAR; PG8_SCHED;
            PG8_LDA(At, 1, 1); PG8_STAGE(PG8_SB(1, 0), b3, voffB); PG8_STAGE(PG8_SB(1, 1), b3 + hstep, voffB); PG8_STAGE(PG8_SA(1, 0), a3, voffA);
            PG8_WAIT_V(8); PG8_WAIT_L(0); PG8_BAR; PG8_MMA(1, 0, At, B0); PG8_MMA(1, 1, At, B1); PG8_BAR; PG8_SCHED;
            } else {
            PG8_LDB(B0, 0, 0); PG8_SCHED; PG8_LDA(At, 0, 0); PG8_STAGE(PG8_SA(1, 1), a1 + hstep, voffA);
            PG8_WAIT_L(8); PG8_BAR; PG8_WAIT_L(0); PG8_MMA(0, 0, At, B0); PG8_BAR; PG8_SCHED;
            PG8_LDB(B1, 0, 1); PG8_STAGE(PG8_SB(0, 0), b2, voffB);
            PG8_BAR; PG8_WAIT_L(0); PG8_MMA(0, 1, At, B1); PG8_BAR;
            PG8_LDA(At, 0, 1); PG8_STAGE(PG8_SA(0, 0), a2, voffA);
            PG8_BAR; PG8_WAIT_L(0); PG8_MMA(1, 0, At, B0); PG8_BAR; PG8_SCHED;
            PG8_STAGE(PG8_SB(0, 1), b2 + hstep, voffB);
            PG8_WAIT_V(6); PG8_BAR; PG8_MMA(1, 1, At, B1); PG8_BAR;
            PG8_LDB(B0, 1, 0); PG8_SCHED; PG8_LDA(At, 1, 0); PG8_STAGE(PG8_SA(0, 1), a2 + hstep, voffA);
            PG8_WAIT_L(8); PG8_BAR; PG8_WAIT_L(0); PG8_MMA(0, 0, At, B0); PG8_BAR; PG8_SCHED;
            PG8_LDB(B1, 1, 1); PG8_STAGE(PG8_SB(1, 0), b3, voffB);
            PG8_BAR; PG8_WAIT_L(0); PG8_MMA(0, 1, At, B1); PG8_BAR;
            PG8_LDA(At, 1, 1); PG8_STAGE(PG8_SA(1, 0), a3, voffA);
            PG8_BAR; PG8_WAIT_L(0); PG8_MMA(1, 0, At, B0); PG8_BAR; PG8_SCHED;
            PG8_STAGE(PG8_SB(1, 1), b3 + hstep, voffB);
            PG8_WAIT_V(6); PG8_BAR; PG8_MMA(1, 1, At, B1); PG8_BAR;
            }
        }
        if constexpr (ALIGN_EPI) { if (wr == 0) PG8_BAR; }
        if constexpr (!Epi::AFTER_DRAIN) { E(acc, cur, wr, wc, fr, fq); S.done(cur); }
        if (!has_next) break;
#pragma unroll
        for (int a = 0; a < 2; ++a)
#pragma unroll
            for (int b = 0; b < 2; ++b)
#pragma unroll
                for (int m = 0; m < 4; ++m)
#pragma unroll
                    for (int n = 0; n < 2; ++n) acc[a][b][m][n] = (f32x4){0.f, 0.f, 0.f, 0.f};
        cur = nxt; cA = nA; cB = nB; ++ui;
        if constexpr (ALIGN_EPI) { if (wr == 1) PG8_BAR; }
    }
    PG8_WAIT_V(0);
    if constexpr (!ALIGN_EPI) { if (wr == 0) PG8_BAR; }
    PG8_BAR;
    if constexpr (Epi::AFTER_DRAIN) { E.fused(acc, cur, wr, wc, fr, fq, lds, wid, lane); S.done(cur); }
#undef PG8_SA
#undef PG8_SB
#undef PG8_STAGE
#undef PG8_LDA
#undef PG8_LDB
#undef PG8_MMA
#undef PG8_WAIT_V
#undef PG8_WAIT_L
#undef PG8_BAR
#undef PG8_SCHED
}
}
#include <hip/hip_bf16.h>
#include <cmath>
namespace attn_body {
using bf16=__hip_bfloat16;
using bf16x8=__attribute__((ext_vector_type(8)))short;
using s16x4=__attribute__((ext_vector_type(4)))short;
using f32x16=__attribute__((ext_vector_type(16)))float;
using u32x4=__attribute__((ext_vector_type(4)))unsigned;
constexpr int BATCH=2,SEQ=4096,D=64,DM=18432,DMO=4096;
constexpr int NW=8,QBLK=32,QB=QBLK*NW,KVBLK=64,NQB=SEQ/QB;
constexpr int ATTN_PITCH=DM, ATTN_UNIT_ROWS=QB;
__device__ __forceinline__ int crow(int r,int hi){return (r&3)+8*(r>>2)+4*hi;}
#define SBAR() __builtin_amdgcn_sched_barrier(0)
__device__ __forceinline__ void cmask(f32x16&p0,f32x16&p1,int jb,int qrel,int hi){
  const float NEG=-INFINITY; int kb=64*jb+4*hi;
  #pragma unroll
  for(int r=0;r<16;++r){int kv=kb+(r&3)+8*(r>>2); if(kv>qrel)p0[r]=NEG; if(kv+32>qrel)p1[r]=NEG;}
}

constexpr int NSLOT=3, SLOTB=8192;
constexpr int LDS_K=0, LDS_V=NSLOT*SLOTB, LDS_WS=2*NSLOT*SLOTB, LDS_OST=LDS_WS+NW*64*4, LDS_BYTES=LDS_OST+NW*4096;
constexpr float C2=0.125f*1.4426950408889634f;
__device__ __forceinline__ void glds16(const void*gsrc,unsigned lds_dst){unsigned keep;
  asm volatile("s_mov_b32 %0, m0\n\ts_mov_b32 m0, %2\n\ts_nop 0\n\tglobal_load_lds_dwordx4 %1, off\n\ts_mov_b32 m0, %0":"=&s"(keep):"v"(gsrc),"s"(lds_dst):"memory");}
__device__ __forceinline__ float max3f(float a,float b,float c){float r;asm("v_max3_f32 %0, %1, %2, %3":"=v"(r):"v"(a),"v"(b),"v"(c));return r;}
__device__ __forceinline__ float max2f(float a,float b){float r;asm("v_max_f32_e32 %0, %1, %2":"=v"(r):"v"(a),"v"(b));return r;}
__device__ __forceinline__ float fadd_s(float a,float b){float r;asm("v_add_f32_e32 %0, %1, %2":"=v"(r):"v"(a),"v"(b));return r;}
__device__ __forceinline__ float fsub_s(float a,float b){float r;asm("v_sub_f32_e32 %0, %1, %2":"=v"(r):"v"(a),"v"(b));return r;}
typedef float f32x2_t __attribute__((ext_vector_type(2))); typedef __bf16 bf16x2_t __attribute__((ext_vector_type(2)));
__device__ __forceinline__ unsigned cvtpk_s(float lo,float hi){f32x2_t v={lo,hi};bf16x2_t b=__builtin_convertvector(v,bf16x2_t);return __builtin_bit_cast(unsigned,b);}
#define WAIT_BAR(N) asm volatile("s_waitcnt vmcnt(" #N ") lgkmcnt(0)\n\ts_barrier":::"memory")

__device__ __forceinline__ void qkt(f32x16&p0,f32x16&p1,const char*Kslot,const bf16x8*qr,const f32x16&negm,int r32,int hi){
  const char*kb=Kslot+hi*1024+r32*16;
  #pragma unroll
  for(int d0=0;d0<4;++d0){
    const bf16x8 b0=*reinterpret_cast<const bf16x8*>(kb+d0*2048);
    const bf16x8 b1=*reinterpret_cast<const bf16x8*>(kb+d0*2048+512);
    if(d0==0){p0=__builtin_amdgcn_mfma_f32_32x32x16_bf16(b0,qr[0],negm,0,0,0);p1=__builtin_amdgcn_mfma_f32_32x32x16_bf16(b1,qr[0],negm,0,0,0);}
    else{p0=__builtin_amdgcn_mfma_f32_32x32x16_bf16(b0,qr[d0],p0,0,0,0);p1=__builtin_amdgcn_mfma_f32_32x32x16_bf16(b1,qr[d0],p1,0,0,0);}}
}
typedef __attribute__((address_space(3))) const char* lds_cptr;
typedef short v4i16_t __attribute__((ext_vector_type(4)));
__device__ __forceinline__ void kload8(bf16x8*kf,lds_cptr kp){
  kf[0]=*(const __attribute__((address_space(3))) bf16x8*)(kp);      kf[1]=*(const __attribute__((address_space(3))) bf16x8*)(kp+512);
  kf[2]=*(const __attribute__((address_space(3))) bf16x8*)(kp+2048); kf[3]=*(const __attribute__((address_space(3))) bf16x8*)(kp+2560);
  kf[4]=*(const __attribute__((address_space(3))) bf16x8*)(kp+4096); kf[5]=*(const __attribute__((address_space(3))) bf16x8*)(kp+4608);
  kf[6]=*(const __attribute__((address_space(3))) bf16x8*)(kp+6144); kf[7]=*(const __attribute__((address_space(3))) bf16x8*)(kp+6656);
}
__device__ __forceinline__ void kload2(bf16x8*kf,lds_cptr kp,int j){ kf[2*j]=*(const __attribute__((address_space(3))) bf16x8*)(kp+j*2048); kf[2*j+1]=*(const __attribute__((address_space(3))) bf16x8*)(kp+j*2048+512); }
__device__ __forceinline__ s16x4 vtr(lds_cptr p){ return __builtin_bit_cast(s16x4,__builtin_amdgcn_ds_read_tr16_b64_v4i16((__attribute__((address_space(3))) v4i16_t*)p)); }
__device__ __forceinline__ float rowmax(const f32x16&p0,const f32x16&p1){
  float a=max3f(p0[0],p0[1],p1[0]),b=max3f(p0[2],p0[3],p1[1]);a=max3f(a,p1[2],p1[3]);
  #pragma unroll
  for(int r=4;r<16;r+=4){a=max3f(a,p0[r],p0[r+1]);b=max3f(b,p0[r+2],p0[r+3]);a=max3f(a,p1[r],p1[r+1]);b=max3f(b,p1[r+2],p1[r+3]);}
  const float m=max2f(a,b);
  auto rr=__builtin_amdgcn_permlane32_swap(__float_as_uint(m),__float_as_uint(m),false,false);
  return max2f(__uint_as_float(rr[0]),__uint_as_float(rr[1]));
}
__device__ __forceinline__ void pv(f32x16*o,int vb,bf16x8 pa0,bf16x8 pa1,bf16x8 pa2,bf16x8 pa3){
  #pragma unroll
  for(int d0=0;d0<2;++d0){s16x4 lo[4],hi[4];
    #pragma unroll
    for(int ks=0;ks<4;++ks){
      asm volatile("ds_read_b64_tr_b16 %0,%1 offset:%c2":"=&v"(lo[ks]):"v"(vb),"i"(d0*4096+ks*1024):"memory");
      asm volatile("ds_read_b64_tr_b16 %0,%1 offset:%c2":"=&v"(hi[ks]):"v"(vb),"i"(d0*4096+ks*1024+512):"memory");}
    asm volatile("s_waitcnt lgkmcnt(0)":::"memory");SBAR();
    #define PK(k) (bf16x8){lo[k][0],lo[k][1],lo[k][2],lo[k][3],hi[k][0],hi[k][1],hi[k][2],hi[k][3]}
    o[d0]=__builtin_amdgcn_mfma_f32_32x32x16_bf16(pa0,PK(0),o[d0],0,0,0);
    o[d0]=__builtin_amdgcn_mfma_f32_32x32x16_bf16(pa1,PK(1),o[d0],0,0,0);
    o[d0]=__builtin_amdgcn_mfma_f32_32x32x16_bf16(pa2,PK(2),o[d0],0,0,0);
    o[d0]=__builtin_amdgcn_mfma_f32_32x32x16_bf16(pa3,PK(3),o[d0],0,0,0);
    #undef PK
  }
}

#ifndef ATTN_STORE16
#define ATTN_STORE16(p,v) (*(u32x4*)(p)=(v))
#endif
template<int THRL> __device__ __forceinline__ void attn_unit(int b,int qb,const bf16*Q,const bf16*__restrict__ K,const bf16*__restrict__ V,bf16*O,char*shm,const int tid){
  const int lane=tid&63,r32=lane&31,hi=lane>>5; const int wid=__builtin_amdgcn_readfirstlane(tid>>6);
  const long rowbase=(long)b*SEQ; const int q0=qb*QB;
  const bf16*Qw=Q+(rowbase+q0+wid*QBLK)*DM;
  const bf16*Kh=K+rowbase*DM,*Vh=V+rowbase*DM;
  const unsigned lds0=(unsigned)(uintptr_t)shm;
  float*wsf=(float*)(shm+LDS_WS)+wid*64;
  const bf16*ksrc=Kh+(long)lane*DM+wid*8;
  const bf16*vsrc=Vh+(long)(16*(wid&3)+(lane>>2))*DM+(wid>>2)*32+(lane&3)*8;
  const unsigned kdst=lds0+LDS_K+wid*1024, vdst=lds0+LDS_V+wid*1024;
  #define DMA_K(t,slot) glds16(ksrc+(long)(t)*KVBLK*DM,(unsigned)__builtin_amdgcn_readfirstlane(kdst+(slot)))
  #define DMA_V(t,slot) glds16(vsrc+(long)(t)*KVBLK*DM,(unsigned)__builtin_amdgcn_readfirstlane(vdst+(slot)))
  const int vb0=(int)(lds0+LDS_V)+((lane>>4)&1)*32+(lane&3)*8+(4*hi+((lane&15)>>2))*64;
  const char*Kbase=shm+LDS_K; bf16x8 kf[8];
  const lds_cptr shm3=(lds_cptr)shm; const lds_cptr kp0=shm3+LDS_K+hi*1024+r32*16; const lds_cptr vp0=shm3+LDS_V+((lane>>4)&1)*32+(lane&3)*8+(4*hi+((lane&15)>>2))*64;
  const int NT=(q0+QB)/KVBLK;
  DMA_K(0,0);DMA_V(0,0);DMA_K(1,SLOTB);
  bf16x8 qr[4];
  #pragma unroll
  for(int d0=0;d0<4;++d0)qr[d0]=*reinterpret_cast<const bf16x8*>(&Qw[(long)r32*DM+d0*16+hi*8]);
  float zz_; asm volatile("v_mov_b32 %0, 0":"=v"(zz_)); float mhat=0.f,l_reg=0.f;f32x16 o[2],negm;
  _Pragma("unroll") for(int r=0;r<16;++r){o[0][r]=zz_;o[1][r]=zz_;negm[r]=zz_;} asm volatile("":"+v"(negm));
  const int qrel=wid*QBLK+r32;
  #define CMASK(P0,P1,t) do{int jb_=(t)-(NT-4); if(jb_>=0)cmask(P0,P1,jb_,qrel,hi);}while(0)
  bool resc=false;
  #define START(P0,P1) do{ const float rm=rowmax(P0,P1); resc=false; \
    { const float dl=rm; mhat=fadd_s(mhat,dl); \
      _Pragma("unroll") for(int r=0;r<16;++r){P0[r]=fsub_s(P0[r],dl);P1[r]=fsub_s(P1[r],dl);} \
      _Pragma("unroll") for(int r=0;r<16;++r)negm[r]=-mhat; asm volatile("":"+v"(negm)); } \
    _Pragma("unroll") for(int r=0;r<16;++r)P0[r]=__builtin_amdgcn_exp2f(P0[r]); }while(0)
  #define RESC() do{ if(resc){ asm volatile("s_waitcnt lgkmcnt(0)":::"memory"); \
      _Pragma("unroll") for(int d_=0;d_<2;++d_) _Pragma("unroll") for(int r=0;r<16;++r)o[d_][r]*=wsf[crow(r,hi)]; } }while(0)
  f32x16 pA0,pA1,pB0,pB1;
  int sl_prev=0,sl_cur=0,sl_next=SLOTB;
  #define ROT() do{sl_prev=sl_cur;sl_cur=sl_next;sl_next=(sl_next==(NSLOT-1)*SLOTB)?0:sl_next+SLOTB;}while(0)
  DMA_K(2,2*SLOTB);
  WAIT_BAR(3);
  qkt(pA0,pA1,Kbase,qr,negm,r32,hi);asm volatile("s_nop 15\n\ts_nop 7":"+v"(pA0),"+v"(pA1));CMASK(pA0,pA1,0);
  START(pA0,pA1);
  _Pragma("unroll") for(int r=0;r<16;++r)pA1[r]=__builtin_amdgcn_exp2f(pA1[r]);
  WAIT_BAR(0);
  DMA_K(3,0);DMA_V(1,SLOTB);
  ROT();
  kload8(kf,kp0+sl_cur);
  WAIT_BAR(2);
  s16x4 vlo[8],vhi[8]; u32x4 pw0,pw1,pw2,pw3;
  #define PKW(P,B) cvtpk_s(P[B],P[B+1])
  #define PAF(k) __builtin_bit_cast(bf16x8,pw##k)
  #define VFR(i) (bf16x8){vlo[i][0],vlo[i][1],vlo[i][2],vlo[i][3],vhi[i][0],vhi[i][1],vhi[i][2],vhi[i][3]}
  #define PIN(x) asm volatile("":"+v"(x))
  #define MX3(a,b,c) __builtin_fmaxf(__builtin_fmaxf((a),(b)),(c))
  #define GAPA(MF,A0,A1,A2,A3,W0,W1,PW) do{ MF; sacc+=A0; sacc+=A1; sacc+=A2; sacc+=A3; PIN(sacc); W0; W1; PIN(PW); SBAR(); }while(0)
  #define EX(v) __builtin_amdgcn_exp2f(v)
  #define GAPB(MF,X,B) do{ MF; X[B]=EX(X[B]); X[B+1]=EX(X[B+1]); X[B+2]=EX(X[B+2]); X[B+3]=EX(X[B+3]); PIN(X); SBAR(); }while(0)
  #define VRD(i) do{ vlo[i]=vtr(vp_+(((i)>>2)*4096+((i)&3)*1024)); vhi[i]=vtr(vp_+(((i)>>2)*4096+((i)&3)*1024+512)); }while(0)
  #define KRD(G,j) do{ if(G){ kload2(kf,kp0+sl_next,j); SBAR(); } }while(0)
  #define STEP(C0,C1,P0,P1,t,GK,GV,GL) do{ SBAR(); \
    const lds_cptr vp_=vp0+sl_prev; \
    VRD(0); SBAR(); float sacc=(P0[0]+P0[1]); \
    GAPA(C0=__builtin_amdgcn_mfma_f32_32x32x16_bf16(kf[0],qr[0],negm,0,0,0), P0[2],P0[3],P0[4],P0[5],     pw0[0]=PKW(P0,0), pw0[1]=PKW(P0,2), pw0); \
    VRD(4); SBAR(); GAPA(C1=__builtin_amdgcn_mfma_f32_32x32x16_bf16(kf[1],qr[0],negm,0,0,0), P0[6],P0[7],P0[8],P0[9],     pw0[2]=PKW(P0,4), pw0[3]=PKW(P0,6), pw0); \
    VRD(1); SBAR(); GAPA(C0=__builtin_amdgcn_mfma_f32_32x32x16_bf16(kf[2],qr[1],C0,0,0,0),   P0[10],P0[11],P0[12],P0[13], pw1[0]=PKW(P0,8), pw1[1]=PKW(P0,10), pw1); \
    VRD(5); SBAR(); GAPA(C1=__builtin_amdgcn_mfma_f32_32x32x16_bf16(kf[3],qr[1],C1,0,0,0),   P0[14],P0[15],P1[0],P1[1],   pw1[2]=PKW(P0,12),pw1[3]=PKW(P0,14), pw1); \
    VRD(2); SBAR(); GAPA(C0=__builtin_amdgcn_mfma_f32_32x32x16_bf16(kf[4],qr[2],C0,0,0,0),   P1[2],P1[3],P1[4],P1[5],     pw2[0]=PKW(P1,0), pw2[1]=PKW(P1,2), pw2); \
    VRD(6); SBAR(); GAPA(C1=__builtin_amdgcn_mfma_f32_32x32x16_bf16(kf[5],qr[2],C1,0,0,0),   P1[6],P1[7],P1[8],P1[9],     pw2[2]=PKW(P1,4), pw2[3]=PKW(P1,6), pw2); \
    VRD(3); SBAR(); GAPA(C0=__builtin_amdgcn_mfma_f32_32x32x16_bf16(kf[6],qr[3],C0,0,0,0),   P1[10],P1[11],P1[12],P1[13], pw3[0]=PKW(P1,8), pw3[1]=PKW(P1,10), pw3); \
    VRD(7); SBAR(); GAPA(C1=__builtin_amdgcn_mfma_f32_32x32x16_bf16(kf[7],qr[3],C1,0,0,0),   P1[14],P1[15],0.f,0.f,       pw3[2]=PKW(P1,12),pw3[3]=PKW(P1,14), pw3); \
    l_reg+=sacc; \
    if(GK){DMA_K((t)+3,sl_cur);} if(GV){DMA_V((t)+1,sl_next);} \
    CMASK(C0,C1,t); \
    { float a=MX3(C0[0],C0[1],C1[0]),b=MX3(C0[2],C0[3],C1[1]); a=MX3(a,C1[2],C1[3]); \
      _Pragma("unroll") for(int r=4;r<16;r+=4){a=MX3(a,C0[r],C0[r+1]);b=MX3(b,C0[r+2],C0[r+3]);a=MX3(a,C1[r],C1[r+1]);b=MX3(b,C1[r+2],C1[r+3]);} \
      float rm=__builtin_fmaxf(a,b); { auto rr=__builtin_amdgcn_permlane32_swap(__float_as_uint(rm),__float_as_uint(rm),false,false); rm=__builtin_fmaxf(__uint_as_float(rr[0]),__uint_as_float(rr[1])); } \
      resc=false; \
      if(__builtin_expect(__any(rm>(float)THRL),0)){ const float dl=__builtin_fmaxf(rm,0.f); mhat+=dl; \
        _Pragma("unroll") for(int r=0;r<16;++r){C0[r]-=dl;C1[r]-=dl;} \
        _Pragma("unroll") for(int r=0;r<16;++r)negm[r]=-mhat; asm volatile("":"+v"(negm)); \
        const float f=__builtin_amdgcn_exp2f(-dl); l_reg*=f; if(hi==0)wsf[r32]=f; resc=true; } } \
    SBAR(); \
    GAPB(o[0]=__builtin_amdgcn_mfma_f32_32x32x16_bf16(PAF(0),VFR(0),o[0],0,0,0), C0,0); \
    GAPB(o[1]=__builtin_amdgcn_mfma_f32_32x32x16_bf16(PAF(0),VFR(4),o[1],0,0,0), C0,4); \
    KRD(GL,0); GAPB(o[0]=__builtin_amdgcn_mfma_f32_32x32x16_bf16(PAF(1),VFR(1),o[0],0,0,0), C0,8); \
    KRD(GL,1); GAPB(o[1]=__builtin_amdgcn_mfma_f32_32x32x16_bf16(PAF(1),VFR(5),o[1],0,0,0), C0,12); \
    KRD(GL,2); GAPB(o[0]=__builtin_amdgcn_mfma_f32_32x32x16_bf16(PAF(2),VFR(2),o[0],0,0,0), C1,0); \
    KRD(GL,3); GAPB(o[1]=__builtin_amdgcn_mfma_f32_32x32x16_bf16(PAF(2),VFR(6),o[1],0,0,0), C1,4); \
    GAPB(o[0]=__builtin_amdgcn_mfma_f32_32x32x16_bf16(PAF(3),VFR(3),o[0],0,0,0), C1,8); \
    GAPB(o[1]=__builtin_amdgcn_mfma_f32_32x32x16_bf16(PAF(3),VFR(7),o[1],0,0,0), C1,12); \
    }while(0)
  int t=1;
  #undef CMASK
  #define CMASK(P0,P1,t) do{}while(0)
  for(;t+5<NT;t+=2){
    STEP(pB0,pB1,pA0,pA1,t,true,true,true);     WAIT_BAR(2); RESC(); ROT();
    STEP(pA0,pA1,pB0,pB1,t+1,true,true,true);   WAIT_BAR(2); RESC(); ROT();
  }
  #undef CMASK
  #define CMASK(P0,P1,t) do{int jb_=(t)-(NT-4); if(jb_>=0)cmask(P0,P1,jb_,qrel,hi);}while(0)
  #define ENDW(tt) do{ if((tt)+3<NT){WAIT_BAR(2);} else if((tt)+2<NT){WAIT_BAR(1);} else {WAIT_BAR(0);} }while(0)
  for(;t+1<NT;t+=2){
    STEP(pB0,pB1,pA0,pA1,t,(t+3<NT),(t+1<NT),(t+1<NT));       ENDW(t);   RESC(); ROT();
    STEP(pA0,pA1,pB0,pB1,t+1,(t+4<NT),(t+2<NT),(t+2<NT));     ENDW(t+1); RESC(); ROT();
  }
  STEP(pB0,pB1,pA0,pA1,NT-1,false,false,false); RESC();
  { float sacc=pB0[0]+pB0[1]; _Pragma("unroll") for(int r=2;r<16;++r)sacc+=pB0[r]; _Pragma("unroll") for(int r=0;r<16;++r)sacc+=pB1[r]; l_reg+=sacc;
    pw0=(u32x4){PKW(pB0,0),PKW(pB0,2),PKW(pB0,4),PKW(pB0,6)};pw1=(u32x4){PKW(pB0,8),PKW(pB0,10),PKW(pB0,12),PKW(pB0,14)};pw2=(u32x4){PKW(pB1,0),PKW(pB1,2),PKW(pB1,4),PKW(pB1,6)};pw3=(u32x4){PKW(pB1,8),PKW(pB1,10),PKW(pB1,12),PKW(pB1,14)};
    SBAR(); pv(o,vb0+sl_cur,PAF(0),PAF(1),PAF(2),PAF(3)); }
  #undef PKW
  #undef PAF
  #undef VFR
  #undef PIN
  #undef MX3
  #undef GAPA
  #undef GAPB
  #undef EX
  #undef VRD
  #undef KRD
  #undef STEP
  #undef ENDW
  {auto rr=__builtin_amdgcn_permlane32_swap(__float_as_uint(l_reg),__float_as_uint(l_reg),false,false);l_reg=__uint_as_float(rr[0])+__uint_as_float(rr[1]);}
  if(hi==0)wsf[32+r32]=l_reg;asm volatile("s_waitcnt lgkmcnt(0)":::"memory");
  float rli[16];
  #pragma unroll
  for(int r=0;r<16;++r)rli[r]=__builtin_amdgcn_rcpf(wsf[32+crow(r,hi)]);
  bf16*Ow=O+(rowbase+q0+wid*QBLK)*DMO;
  { bf16*stg=(bf16*)(shm+LDS_OST)+wid*2048;
    #pragma unroll
    for(int r=0;r<16;++r){const int orow=crow(r,hi);
      #pragma unroll
      for(int d0=0;d0<2;++d0)stg[orow*64+d0*32+r32]=__float2bfloat16(o[d0][r]*rli[r]);}
    asm volatile("s_waitcnt lgkmcnt(0)":::"memory");
    #pragma unroll
    for(int i=0;i<4;++i){const int row=i*8+(lane>>3),ch=lane&7; const u32x4 v=*(const u32x4*)(stg+row*64+ch*8); ATTN_STORE16(Ow+(long)row*DMO+ch*8,v);} }
  asm volatile("s_waitcnt lgkmcnt(0)\n\ts_barrier":::"memory");
  #undef DMA_K
  #undef DMA_V
  #undef CMASK
  #undef START
  #undef RESC
  #undef ROT
}
constexpr int ATTN_LDS_BYTES=LDS_BYTES;
#undef SBAR
#undef WAIT_BAR
}
namespace cg = cooperative_groups;
#define LAS __attribute__((address_space(3)))
typedef unsigned short bf16;
typedef unsigned v4u __attribute__((ext_vector_type(4)));
typedef unsigned v2u __attribute__((ext_vector_type(2)));
typedef float f32x4 __attribute__((ext_vector_type(4)));
typedef short bf16x8 __attribute__((ext_vector_type(8)));

constexpr int NWAVES = 8, NTHR = 512;
constexpr int TOK = 8192, SEQL = 4096, DMOD = 2048, NIN = 18448, NPP = 18432, DEPTH = 4;
constexpr int C_AQ = 0, C_AK = 1024, C_AV = 2048, C_AG = 4096, C_BQ = 6144, C_BK = 8192, C_BV = 10240, C_BG = 12288, C_MA = 14336, C_MB = 16384;
constexpr float EPSN = 1e-6f;
constexpr size_t MiB = 1u << 20;
constexpr size_t WS_WIN = 2 * MiB;
constexpr size_t WS_WABO = 290 * MiB;
constexpr size_t WS_H = 386 * MiB;
constexpr size_t WS_P = 418 * MiB;
constexpr size_t WS_ALR = 706 * MiB;
constexpr size_t WS_QG = 707 * MiB;
constexpr size_t WS_KHT = 723 * MiB;
constexpr size_t WS_VTG = 739 * MiB;
constexpr size_t WS_DG = 771 * MiB;
constexpr size_t WS_OG = 772 * MiB;
constexpr size_t WS_OB = 836 * MiB;
constexpr size_t WS_OA = 900 * MiB;
constexpr size_t WS_OBF = 932 * MiB;
constexpr size_t WS_T1 = 964 * MiB;
constexpr size_t WS_MG = 1028 * MiB;
constexpr size_t WS_OUT = 1060 * MiB;
constexpr size_t WS_PS = 1124 * MiB;
constexpr size_t WS_END = 1125 * MiB;
constexpr int LDS_BYTES = 147456;
constexpr int MISC_OFF = 131072 + 512;
constexpr int CW_BAR = 4096;
constexpr size_t CTL_ZERO_BYTES = 1 * MiB;

#define LDS_WAIT() asm volatile("s_waitcnt lgkmcnt(0)" ::: "memory")
__device__ __forceinline__ unsigned f2bf(float f) { unsigned u = __builtin_bit_cast(unsigned, f); return (u + 0x7fffu + ((u >> 16) & 1u)) >> 16; }
__device__ __forceinline__ unsigned pk2(float lo, float hi) { return f2bf(lo) | (f2bf(hi) << 16); }
__device__ __forceinline__ float bf2f(unsigned short b) { return __uint_as_float(((unsigned)b) << 16); }
__device__ __forceinline__ float blo(unsigned w) { return __uint_as_float(w << 16); }
__device__ __forceinline__ float bhi(unsigned w) { return __uint_as_float(w & 0xffff0000u); }
__device__ __forceinline__ float shx(float v, int m, int lane) { return __uint_as_float(__builtin_amdgcn_ds_bpermute(((lane ^ m) & 63) << 2, __float_as_uint(v))); }
__device__ __forceinline__ float wave_sum(float v, int lane) {
#pragma unroll
    for (int o = 1; o < 64; o <<= 1) v += shx(v, o, lane);
    return v;
}
__device__ __forceinline__ float fexp(float x) { return __builtin_amdgcn_exp2f(1.4426950408889634f * x); }
__device__ __forceinline__ float siluf(float x) { return x * __builtin_amdgcn_rcpf(1.0f + fexp(-x)); }

#define XB_TMO      128
#define XB_XCNT(j)  (256  + 64 * (j))
#define XB_XSUB(j)  (1280 + 64 * (j))
#define XB_XGEN(j)  (2304 + 64 * (j))
#define XB_TOP      3328
#define XB_TOPGEN   3392
#define XCD_BAR_WORDS 3456
#define XB_SPIN_CAP (1u << 18)

__device__ __forceinline__ unsigned xb_ld(unsigned* p)              { return __hip_atomic_load(p, __ATOMIC_RELAXED, __HIP_MEMORY_SCOPE_AGENT); }
__device__ __forceinline__ unsigned xb_add(unsigned* p, unsigned v) { return __hip_atomic_fetch_add(p, v, __ATOMIC_RELAXED, __HIP_MEMORY_SCOPE_AGENT); }
__device__ __forceinline__ unsigned xb_xcc_id() { return (unsigned)__builtin_amdgcn_s_getreg((3 << 11) | 20) & 0xFu; }
#define XB_SPIN(cond, bar) do { unsigned _sp = 0; while (cond) { __builtin_amdgcn_s_sleep(1); \
    if ((++_sp & 255u) == 0u) { if (xb_ld(&(bar)[XB_TMO])) break; if (_sp > XB_SPIN_CAP) { atomicAdd(&(bar)[XB_TMO], 1u); break; } } } } while (0)

struct XcdBarrier {
    unsigned* bar; unsigned x;
    volatile LAS unsigned* st;
};

__device__ __forceinline__ XcdBarrier xcd_barrier_post(unsigned* bar, volatile LAS unsigned* st, int tid) {
    XcdBarrier b; b.bar = bar; b.x = xb_xcc_id(); b.st = st;
    if (tid == 0) (void)xb_add(&bar[XB_XCNT(b.x)], 1u);
    return b;
}
__device__ __forceinline__ void xcd_barrier_complete(unsigned* bar, unsigned x, unsigned& nloc, unsigned& nx) {
    const unsigned G = gridDim.x * gridDim.y * gridDim.z;
    unsigned sum, cnt, mine, sp = 0u;
    for (;;) {
        sum = 0u; cnt = 0u; mine = 0u;
#pragma unroll
        for (unsigned j = 0; j < 16; ++j) { const unsigned c = xb_ld(&bar[XB_XCNT(j)]); sum += c; cnt += (c > 0u) ? 1u : 0u; mine = (j == x) ? c : mine; }
        if (sum == G) break;
        __builtin_amdgcn_s_sleep(1);
        if ((++sp & 255u) == 0u) { if (xb_ld(&bar[XB_TMO])) break; if (sp > XB_SPIN_CAP) { atomicAdd(&bar[XB_TMO], 1u); break; } }
    }
    nloc = mine > 0u ? mine : 1u; nx = cnt > 0u ? cnt : 1u;
}

__device__ __forceinline__ void xcd_barrier(const XcdBarrier& b, int tid) {
    asm volatile("s_waitcnt vmcnt(0)" ::: "memory");
    __syncthreads();
    if (tid == 0) {
        unsigned* bar = b.bar;
        __builtin_amdgcn_s_waitcnt(0);
        unsigned nloc = b.st[0], nx = b.st[1];
        if (nloc == 0u) { xcd_barrier_complete(bar, b.x, nloc, nx); b.st[0] = nloc; b.st[1] = nx; }
        const unsigned old = xb_add(&bar[XB_XSUB(b.x)], 1u);
        const unsigned gen = old / nloc;
        if (old + 1u == (gen + 1u) * nloc) {
            __builtin_amdgcn_fence(__ATOMIC_RELEASE, "agent");
            asm volatile("s_waitcnt vmcnt(0)" ::: "memory");
            const unsigned og = xb_add(&bar[XB_TOP], 1u);
            const unsigned tg = og / nx;
            if (og + 1u == (tg + 1u) * nx) xb_add(&bar[XB_TOPGEN], 1u);
            else XB_SPIN(xb_ld(&bar[XB_TOPGEN]) == tg, bar);
            __builtin_amdgcn_fence(__ATOMIC_ACQUIRE, "agent");
            xb_add(&bar[XB_XGEN(b.x)], 1u);
            asm volatile("s_waitcnt vmcnt(0)" ::: "memory");
        } else {
            XB_SPIN(xb_ld(&bar[XB_XGEN(b.x)]) == gen, bar);
            __builtin_amdgcn_fence(__ATOMIC_ACQUIRE, "agent");
            asm volatile("s_waitcnt vmcnt(0)" ::: "memory");
        }
    }
    __syncthreads();
}

__device__ __forceinline__ void transpose_item(const float* W, int ldw, int K, int N, bf16* WT, LAS float* scr, int item, int lane) {
    const int nblk = N / 32, kb = item / nblk, nb = item % nblk, k0 = 64 * kb, n0 = 32 * nb;
#pragma unroll 8
    for (int i = 0; i < 32; ++i) { const int kk = 2 * i + (lane >> 5); scr[kk * 33 + (lane & 31)] = W[(size_t)(k0 + kk) * ldw + n0 + (lane & 31)]; }
    LDS_WAIT(); asm volatile("" ::: "memory");
    const int c = lane & 7;
#pragma unroll
    for (int j = 0; j < 4; ++j) { const int n = (lane >> 3) + 8 * j; const LAS float* s = scr + (8 * c) * 33 + n;
        v4u o; o.x = pk2(s[0 * 33], s[1 * 33]); o.y = pk2(s[2 * 33], s[3 * 33]); o.z = pk2(s[4 * 33], s[5 * 33]); o.w = pk2(s[6 * 33], s[7 * 33]);
        *(v4u*)(WT + (size_t)(n0 + n) * K + k0 + 8 * c) = o; }
    LDS_WAIT(); asm volatile("" ::: "memory");
}

struct Args { const float* in[12]; float* out; unsigned char* ws; int ph_lo, ph_hi; };
typedef const Args __attribute__((address_space(4))) CArgs;

__device__ __forceinline__ void phase_weights(CArgs& a, LAS unsigned char* lds, int gw, int NGW, int wave, int lane) {
    LAS float* scr = (LAS float*)(lds + wave * 16384);
    constexpr int I1 = 32 * (6144 / 32), I2 = 32 * (12288 / 32), I3 = 32 * (2048 / 32), PER = I1 + I2 + 3 * I3;
    for (int it = gw; it < DEPTH * PER; it += NGW) {
        const int l = it / PER; int r = it % PER;
        const float* win = a.in[3] + (size_t)l * DMOD * NIN;
        bf16* wt = (bf16*)(a.ws + WS_WIN) + (size_t)l * NPP * DMOD;
        bf16* wabo = (bf16*)(a.ws + WS_WABO) + (size_t)l * 3 * DMOD * DMOD;
        if (r < I1) { transpose_item(win, NIN, DMOD, 6144, wt, scr, r, lane); continue; } r -= I1;
        if (r < I2) { transpose_item(win + 6160, NIN, DMOD, 12288, wt + (size_t)6144 * DMOD, scr, r, lane); continue; } r -= I2;
        if (r < I3) { transpose_item(a.in[9] + (size_t)l * DMOD * DMOD, DMOD, DMOD, DMOD, wabo, scr, r, lane); continue; } r -= I3;
        if (r < I3) { transpose_item(a.in[10] + (size_t)l * DMOD * DMOD, DMOD, DMOD, DMOD, wabo + (size_t)DMOD * DMOD, scr, r, lane); continue; } r -= I3;
        transpose_item(a.in[11] + (size_t)l * DMOD * DMOD, DMOD, DMOD, DMOD, wabo + (size_t)2 * DMOD * DMOD, scr, r, lane);
    }
}

__device__ __forceinline__ void phase_norm(CArgs& a, LAS unsigned char* lds, int l, int gw, int NGW, int wave, int lane) {
    const float* xprev = (l <= 1) ? a.in[0] : a.out;
    const float* OUT = (const float*)(a.ws + WS_OUT); const float* PS = (const float*)(a.ws + WS_PS);
    bf16* H = (bf16*)(a.ws + WS_H); float* ALR = (float*)(a.ws + WS_ALR);
    for (int row = gw; row < TOK; row += NGW) {
        const f32x4* xr = (const f32x4*)(xprev + (size_t)row * DMOD) + lane;
        f32x4 v[8];
#pragma unroll
        for (int j = 0; j < 8; ++j) v[j] = xr[64 * j];
        if (l > 0) {
            const f32x4* orow = (const f32x4*)(OUT + (size_t)row * DMOD) + lane;
            const f32x4* gp = (const f32x4*)(a.in[2] + (size_t)(l - 1) * DMOD) + lane;
            float ps = (lane < 32) ? PS[(size_t)row * 32 + lane] : 0.f;
            const float rs = 1.0f / sqrtf(wave_sum(ps, lane) * (1.0f / DMOD) + EPSN);
            f32x4* xo = (f32x4*)(a.out + (size_t)row * DMOD) + lane;
#pragma unroll
            for (int j = 0; j < 8; ++j) { v[j] = v[j] + orow[64 * j] * rs * gp[64 * j]; xo[64 * j] = v[j]; }
        }
        if (l == DEPTH) continue;
        float s = 0.f;
#pragma unroll
        for (int j = 0; j < 8; ++j) s += (v[j].x * v[j].x + v[j].y * v[j].y) + (v[j].z * v[j].z + v[j].w * v[j].w);
        const float rs2 = 1.0f / sqrtf(wave_sum(s, lane) * (1.0f / DMOD) + EPSN);
        const f32x4* gq = (const f32x4*)(a.in[1] + (size_t)l * DMOD) + lane;
        unsigned long long* o8 = (unsigned long long*)(H + (size_t)row * DMOD) + lane;
        LAS float* hl = (LAS float*)(lds + wave * 8192);
#pragma unroll
        for (int j = 0; j < 8; ++j) {
            v[j] = v[j] * rs2 * gq[64 * j];
            o8[64 * j] = (unsigned long long)pk2(v[j].x, v[j].y) | ((unsigned long long)pk2(v[j].z, v[j].w) << 32);
            *(LAS f32x4*)(hl + 256 * j + 4 * lane) = v[j];
        }
        LDS_WAIT(); asm volatile("" ::: "memory");
        float acc[16];
#pragma unroll
        for (int i = 0; i < 16; ++i) acc[i] = 0.f;
        const float* wl = a.in[3] + (size_t)l * DMOD * NIN + 6144 + (size_t)lane * NIN;
#pragma unroll 2
        for (int kk = 0; kk < 32; ++kk) {
            const float hv = hl[kk * 64 + lane];
            const f32x4* wp = (const f32x4*)(wl + (size_t)kk * 64 * NIN);
            const f32x4 w0 = wp[0], w1 = wp[1], w2 = wp[2], w3 = wp[3];
            acc[0] += hv * w0.x; acc[1] += hv * w0.y; acc[2] += hv * w0.z; acc[3] += hv * w0.w;
            acc[4] += hv * w1.x; acc[5] += hv * w1.y; acc[6] += hv * w1.z; acc[7] += hv * w1.w;
            acc[8] += hv * w2.x; acc[9] += hv * w2.y; acc[10] += hv * w2.z; acc[11] += hv * w2.w;
            acc[12] += hv * w3.x; acc[13] += hv * w3.y; acc[14] += hv * w3.z; acc[15] += hv * w3.w;
        }
        LDS_WAIT(); asm volatile("" ::: "memory");
#pragma unroll
        for (int i = 0; i < 16; ++i) acc[i] = wave_sum(acc[i], lane);
        if (lane == 0) { f32x4* ap = (f32x4*)(ALR + (size_t)row * 16);
            ap[0] = (f32x4){acc[0], acc[1], acc[2], acc[3]}; ap[1] = (f32x4){acc[4], acc[5], acc[6], acc[7]};
            ap[2] = (f32x4){acc[8], acc[9], acc[10], acc[11]}; ap[3] = (f32x4){acc[12], acc[13], acc[14], acc[15]}; }
    }
}

constexpr int QPB = 528;
constexpr int TPB = 144;
__device__ __forceinline__ bf16x8 ldfrag(const LAS unsigned char* p) { return *(const LAS bf16x8*)p; }

__device__ __forceinline__ void load_v_half(LAS unsigned char* VT, const bf16* P, int token0, int h, int vh, int u, int nthr) {
    for (int c = u; c < 2048; c += nthr) {
        const int chi = c >> 6, ln = c & 63; const int s = (chi & 3) * 16 + (ln & 15), ch = (chi >> 2) * 4 + (ln >> 4);
        const v4u v = *(const v4u*)(P + (size_t)(token0 + s) * NPP + C_AV + h * 512 + vh * 256 + ch * 8);
        LAS unsigned short* d = (LAS unsigned short*)(VT + (ch * 8) * TPB + s * 2);
        d[0 * (TPB / 2)] = (unsigned short)(v.x & 0xffffu); d[1 * (TPB / 2)] = (unsigned short)(v.x >> 16);
        d[2 * (TPB / 2)] = (unsigned short)(v.y & 0xffffu); d[3 * (TPB / 2)] = (unsigned short)(v.y >> 16);
        d[4 * (TPB / 2)] = (unsigned short)(v.z & 0xffffu); d[5 * (TPB / 2)] = (unsigned short)(v.z >> 16);
        d[6 * (TPB / 2)] = (unsigned short)(v.w & 0xffffu); d[7 * (TPB / 2)] = (unsigned short)(v.w >> 16);
    }
}

__device__ __forceinline__ void gla_intra_unit(CArgs& a, int l, LAS unsigned char* lds, int b, int n, int h, const int tid) {
    const int lane = tid & 63, wid = __builtin_amdgcn_readfirstlane(tid >> 6), fr = lane & 15, fq = lane >> 4;
    LAS unsigned char* QT = lds; LAS unsigned char* KT = lds + 33792; LAS unsigned char* AS = lds + 67584; LAS unsigned char* VT = lds + 76800;
    const int token0 = b * SEQL + n * 64; const int unit = (b * 64 + n) * 4 + h;
    const bf16* P = (const bf16*)(a.ws + WS_P);
    bf16* QG = (bf16*)(a.ws + WS_QG); bf16* KHT = (bf16*)(a.ws + WS_KHT) + (size_t)unit * 256 * 64; bf16* VTG = (bf16*)(a.ws + WS_VTG) + (size_t)unit * 512 * 64;
    float* DG = (float*)(a.ws + WS_DG) + (size_t)unit * 256; float* OG = (float*)(a.ws + WS_OG);
    const float* ALR = (const float*)(a.ws + WS_ALR);
    if (tid < 256) {
        const int k = tid;
        float w2c[16];
#pragma unroll
        for (int r = 0; r < 16; ++r) w2c[r] = a.in[4][((size_t)l * 16 + r) * 1024 + h * 256 + k];
        const float bias = a.in[5][(size_t)l * 1024 + h * 256 + k];
        float bc = 0.f;
#pragma unroll 4
        for (int t = 0; t < 64; ++t) {
            const float* al = ALR + (size_t)(token0 + t) * 16;
            float lg = bias;
#pragma unroll
            for (int r = 0; r < 16; ++r) lg += al[r] * w2c[r];
            const float ls = fminf(lg, 0.f) - __logf(1.0f + fexp(-fabsf(lg)));
            bc += ls * 0.0625f;
            const float e = fexp(bc), ei = fexp(-bc);
            const float q = bf2f(P[(size_t)(token0 + t) * NPP + C_AQ + h * 256 + k]);
            const float kk = bf2f(P[(size_t)(token0 + t) * NPP + C_AK + h * 256 + k]);
            const unsigned short qb = (unsigned short)f2bf(q * e), kb = (unsigned short)f2bf(kk * ei);
            *(LAS unsigned short*)(QT + t * QPB + k * 2) = qb;
            *(LAS unsigned short*)(KT + t * QPB + k * 2) = kb;
            QG[(size_t)(token0 + t) * 1024 + h * 256 + k] = qb;
        }
        const float el = fexp(bc);
        DG[k] = el;
        LDS_WAIT();
#pragma unroll
        for (int t8 = 0; t8 < 8; ++t8) {
            float kv[8];
#pragma unroll
            for (int i = 0; i < 8; ++i) kv[i] = bf2f(*(const LAS unsigned short*)(KT + (t8 * 8 + i) * QPB + k * 2)) * el;
            v4u o; o.x = pk2(kv[0], kv[1]); o.y = pk2(kv[2], kv[3]); o.z = pk2(kv[4], kv[5]); o.w = pk2(kv[6], kv[7]);
            *(v4u*)(KHT + (size_t)k * 64 + t8 * 8) = o;
        }
    } else {
        load_v_half(VT, P, token0, h, 0, tid - 256, 256);
    }
    __syncthreads();
#pragma unroll
    for (int tt = 0; tt < 2; ++tt) {
        const int tile = 2 * wid + tt, si = tile >> 2, ti = tile & 3;
        f32x4 acc = (f32x4){0.f, 0.f, 0.f, 0.f};
        if (si <= ti) {
#pragma unroll
            for (int kk = 0; kk < 8; ++kk) {
                const bf16x8 X = ldfrag(KT + (si * 16 + fr) * QPB + (kk * 32 + 8 * fq) * 2);
                const bf16x8 Y = ldfrag(QT + (ti * 16 + fr) * QPB + (kk * 32 + 8 * fq) * 2);
                acc = __builtin_amdgcn_mfma_f32_16x16x32_bf16(X, Y, acc, 0, 0, 0);
            }
        }
        const int s0 = si * 16 + 4 * fq, t = ti * 16 + fr;
#pragma unroll
        for (int r = 0; r < 4; ++r) if (s0 + r > t) acc[r] = 0.f;
        v2u w; w.x = pk2(acc[0], acc[1]); w.y = pk2(acc[2], acc[3]);
        *(LAS v2u*)(AS + t * TPB + s0 * 2) = w;
    }
    __syncthreads();
#pragma unroll 1
    for (int vh = 0; vh < 2; ++vh) {
        if (vh == 1) { load_v_half(VT, P, token0, h, 1, tid, NTHR); __syncthreads(); }
        bf16x8 Yf[4][2];
#pragma unroll
        for (int tt = 0; tt < 4; ++tt)
#pragma unroll
            for (int ks = 0; ks < 2; ++ks) Yf[tt][ks] = ldfrag(AS + (tt * 16 + fr) * TPB + (ks * 32 + 8 * fq) * 2);
#pragma unroll
        for (int v2 = 0; v2 < 2; ++v2) {
            const int vt = 2 * wid + v2;
            const bf16x8 X0 = ldfrag(VT + (vt * 16 + fr) * TPB + (8 * fq) * 2), X1 = ldfrag(VT + (vt * 16 + fr) * TPB + (32 + 8 * fq) * 2);
#pragma unroll
            for (int tt = 0; tt < 4; ++tt) {
                f32x4 acc = (f32x4){0.f, 0.f, 0.f, 0.f};
                acc = __builtin_amdgcn_mfma_f32_16x16x32_bf16(X0, Yf[tt][0], acc, 0, 0, 0);
                acc = __builtin_amdgcn_mfma_f32_16x16x32_bf16(X1, Yf[tt][1], acc, 0, 0, 0);
                *(f32x4*)(OG + (size_t)(token0 + tt * 16 + fr) * DMOD + h * 512 + vh * 256 + vt * 16 + 4 * fq) = acc;
            }
        }
#pragma unroll
        for (int j = 0; j < 4; ++j) { const int idx = tid + j * NTHR, vrow = idx >> 3, c8 = idx & 7;
            *(v4u*)(VTG + (size_t)(vh * 256 + vrow) * 64 + c8 * 8) = *(const LAS v4u*)(VT + vrow * TPB + c8 * 16); }
        __syncthreads();
    }
}

__device__ __forceinline__ void gla_inter_unit(CArgs& a, LAS unsigned char* lds, int bh, int vs, const int tid) {
    const int lane = tid & 63, wid = __builtin_amdgcn_readfirstlane(tid >> 6), fr = lane & 15, fq = lane >> 4;
    LAS unsigned char* QT = lds; LAS unsigned char* KH = lds + 33792; LAS unsigned char* VS = lds + 70656; LAS unsigned char* ST = lds + 75264;
    const int b = bh >> 2, h = bh & 3, v0 = vs * 32;
    const bf16* QG = (const bf16*)(a.ws + WS_QG); const bf16* KHT = (const bf16*)(a.ws + WS_KHT); const bf16* VTG = (const bf16*)(a.ws + WS_VTG);
    const float* DG = (const float*)(a.ws + WS_DG); float* OG = (float*)(a.ws + WS_OG);
    f32x4 sacc[2][2];
#pragma unroll
    for (int i = 0; i < 2; ++i)
#pragma unroll
        for (int j = 0; j < 2; ++j) sacc[i][j] = (f32x4){0.f, 0.f, 0.f, 0.f};
    for (int i = tid; i < 16896 / 4; i += NTHR) ((LAS unsigned*)ST)[i] = 0u;
    const int vt = wid & 1, tt = wid >> 1;
#pragma unroll 1
    for (int n = 0; n < 64; ++n) {
        const int token0 = b * SEQL + n * 64; const int unit = (b * 64 + n) * 4 + h;
#pragma unroll
        for (int j = 0; j < 4; ++j) { const int idx = tid + j * NTHR, row = idx >> 5, c = idx & 31;
            *(LAS v4u*)(QT + row * QPB + c * 16) = *(const v4u*)(QG + (size_t)(token0 + row) * 1024 + h * 256 + c * 8); }
#pragma unroll
        for (int j = 0; j < 4; ++j) { const int idx = tid + j * NTHR, row = idx >> 3, c = idx & 7;
            *(LAS v4u*)(KH + row * TPB + c * 16) = *(const v4u*)(KHT + ((size_t)unit * 256 + row) * 64 + c * 8); }
        if (tid < 256) { const int row = tid >> 3, c = tid & 7;
            *(LAS v4u*)(VS + row * TPB + c * 16) = *(const v4u*)(VTG + ((size_t)unit * 512 + v0 + row) * 64 + c * 8); }
        f32x4 dv[2];
#pragma unroll
        for (int kt = 0; kt < 2; ++kt) dv[kt] = *(const f32x4*)(DG + (size_t)unit * 256 + 32 * wid + 16 * kt + 4 * fq);
        __syncthreads();
        {
            f32x4 acc = (f32x4){0.f, 0.f, 0.f, 0.f};
#pragma unroll
            for (int kk = 0; kk < 8; ++kk) {
                const bf16x8 X = ldfrag(ST + (vt * 16 + fr) * QPB + (kk * 32 + 8 * fq) * 2);
                const bf16x8 Y = ldfrag(QT + (tt * 16 + fr) * QPB + (kk * 32 + 8 * fq) * 2);
                acc = __builtin_amdgcn_mfma_f32_16x16x32_bf16(X, Y, acc, 0, 0, 0);
            }
            float* op = OG + (size_t)(token0 + tt * 16 + fr) * DMOD + h * 512 + v0 + vt * 16 + 4 * fq;
            f32x4 o = *(const f32x4*)op; o = o + acc; *(f32x4*)op = o;
        }
#pragma unroll
        for (int kt = 0; kt < 2; ++kt)
#pragma unroll
            for (int v2 = 0; v2 < 2; ++v2) {
                f32x4 s = sacc[kt][v2] * dv[kt];
#pragma unroll
                for (int ts = 0; ts < 2; ++ts) {
                    const bf16x8 X = ldfrag(KH + (32 * wid + 16 * kt + fr) * TPB + (ts * 32 + 8 * fq) * 2);
                    const bf16x8 Y = ldfrag(VS + (v2 * 16 + fr) * TPB + (ts * 32 + 8 * fq) * 2);
                    s = __builtin_amdgcn_mfma_f32_16x16x32_bf16(X, Y, s, 0, 0, 0);
                }
                sacc[kt][v2] = s;
            }
        __syncthreads();
#pragma unroll
        for (int kt = 0; kt < 2; ++kt)
#pragma unroll
            for (int v2 = 0; v2 < 2; ++v2) { v2u w; w.x = pk2(sacc[kt][v2][0], sacc[kt][v2][1]); w.y = pk2(sacc[kt][v2][2], sacc[kt][v2][3]);
                *(LAS v2u*)(ST + (v2 * 16 + fr) * QPB + (32 * wid + 16 * kt + 4 * fq) * 2) = w; }
    }
    __syncthreads();
}

__device__ __forceinline__ void phase_post(CArgs& a, int l, int gw, int NGW, int lane) {
    const bf16* P = (const bf16*)(a.ws + WS_P); const float* OG = (const float*)(a.ws + WS_OG); const bf16* OB = (const bf16*)(a.ws + WS_OB);
    bf16* OA = (bf16*)(a.ws + WS_OA); bf16* OBF = (bf16*)(a.ws + WS_OBF);
    const float* dl = a.in[7] + (size_t)l * 256;
    const float s1 = wave_sum(dl[lane] * dl[64 + lane], lane), s2 = wave_sum(dl[128 + lane] * dl[192 + lane], lane);
    const float lam_init = 0.8f - 0.6f * expf(-0.3f * (float)l);
    const float lam = expf(s1) - expf(s2) + lam_init;
    const float oml = 1.0f - lam_init;
    const f32x4* gg = (const f32x4*)(a.in[6] + (size_t)l * 512 + lane * 8);
    const f32x4 gg0 = gg[0], gg1 = gg[1];
    const int hd = lane >> 2, sub = lane & 3;
    for (int row = gw; row < TOK; row += NGW) {
#pragma unroll
        for (int h = 0; h < 4; ++h) {
            const f32x4* op = (const f32x4*)(OG + (size_t)row * DMOD + h * 512 + lane * 8);
            const f32x4 o0 = op[0], o1 = op[1];
            const float ss = wave_sum((o0.x * o0.x + o0.y * o0.y) + (o0.z * o0.z + o0.w * o0.w) + (o1.x * o1.x + o1.y * o1.y) + (o1.z * o1.z + o1.w * o1.w), lane);
            const float rs = 1.0f / sqrtf(ss * (1.0f / 512.0f) + EPSN);
            const v4u ag = *(const v4u*)(P + (size_t)row * NPP + C_AG + h * 512 + lane * 8);
            v4u w;
            w.x = pk2(o0.x * rs * gg0.x * siluf(blo(ag.x)), o0.y * rs * gg0.y * siluf(bhi(ag.x)));
            w.y = pk2(o0.z * rs * gg0.z * siluf(blo(ag.y)), o0.w * rs * gg0.w * siluf(bhi(ag.y)));
            w.z = pk2(o1.x * rs * gg1.x * siluf(blo(ag.z)), o1.y * rs * gg1.y * siluf(bhi(ag.z)));
            w.w = pk2(o1.z * rs * gg1.z * siluf(blo(ag.w)), o1.w * rs * gg1.w * siluf(bhi(ag.w)));
            *(v4u*)(OA + (size_t)row * DMOD + h * 512 + lane * 8) = w;
        }
        const v4u* p1 = (const v4u*)(OB + (size_t)row * 4096 + (2 * hd) * 128 + sub * 32);
        const v4u* p2 = (const v4u*)(OB + (size_t)row * 4096 + (2 * hd + 1) * 128 + sub * 32);
        float o[32]; float ss = 0.f;
#pragma unroll
        for (int c = 0; c < 4; ++c) { const v4u x = p1[c], y = p2[c];
            o[8 * c + 0] = blo(x.x) - lam * blo(y.x); o[8 * c + 1] = bhi(x.x) - lam * bhi(y.x);
            o[8 * c + 2] = blo(x.y) - lam * blo(y.y); o[8 * c + 3] = bhi(x.y) - lam * bhi(y.y);
            o[8 * c + 4] = blo(x.z) - lam * blo(y.z); o[8 * c + 5] = bhi(x.z) - lam * bhi(y.z);
            o[8 * c + 6] = blo(x.w) - lam * blo(y.w); o[8 * c + 7] = bhi(x.w) - lam * bhi(y.w); }
#pragma unroll
        for (int i = 0; i < 32; ++i) ss += o[i] * o[i];
        ss += shx(ss, 1, lane); ss += shx(ss, 2, lane);
        const float rs = oml / sqrtf(ss * (1.0f / 128.0f) + EPSN);
        const v4u* pg = (const v4u*)(P + (size_t)row * NPP + C_BG + hd * 128 + sub * 32);
        const f32x4* gn = (const f32x4*)(a.in[8] + (size_t)l * 128 + sub * 32);
        v4u* po = (v4u*)(OBF + (size_t)row * DMOD + hd * 128 + sub * 32);
#pragma unroll
        for (int c = 0; c < 4; ++c) { const v4u g = pg[c]; const f32x4 n0 = gn[2 * c], n1 = gn[2 * c + 1]; v4u w;
            w.x = pk2(o[8 * c + 0] * rs * n0.x * siluf(blo(g.x)), o[8 * c + 1] * rs * n0.y * siluf(bhi(g.x)));
            w.y = pk2(o[8 * c + 2] * rs * n0.z * siluf(blo(g.y)), o[8 * c + 3] * rs * n0.w * siluf(bhi(g.y)));
            w.z = pk2(o[8 * c + 4] * rs * n1.x * siluf(blo(g.z)), o[8 * c + 5] * rs * n1.y * siluf(bhi(g.z)));
            w.w = pk2(o[8 * c + 6] * rs * n1.z * siluf(blo(g.w)), o[8 * c + 7] * rs * n1.w * siluf(bhi(g.w)));
            po[c] = w; }
    }
}

constexpr int N_PHASES = 2 + 7 * DEPTH;
#ifndef PHMASK
#define PHMASK 0x1ff
#endif
__global__ void __launch_bounds__(NTHR, 2) mega_fwd(const Args args_) {
    extern __shared__ __attribute__((aligned(16))) unsigned char lds_raw[];
    LAS unsigned char* lds = (LAS unsigned char*)lds_raw;
    cg::grid_group grid = cg::this_grid();
    const int G = gridDim.x;
    const int wave0 = __builtin_amdgcn_readfirstlane((int)threadIdx.x >> 6);
    volatile LAS unsigned* MISC = (volatile LAS unsigned*)(lds + MISC_OFF);
    if (threadIdx.x < 32) MISC[threadIdx.x] = 0u;
    __syncthreads();
    { XcdBarrier b0 = xcd_barrier_post((unsigned*)(args_.ws) + CW_BAR, MISC + 8, (int)threadIdx.x); (void)b0; }
    grid.sync();
    const int ph_lo = args_.ph_lo;
    for (int ph = ph_lo; ; ++ph) {
        int lane_, wv_ = wave0, bx = blockIdx.x;
        asm volatile("v_mbcnt_lo_u32_b32 %0, -1, 0\n\tv_mbcnt_hi_u32_b32 %0, -1, %0" : "=v"(lane_));
        CArgs* ap = (CArgs*)__builtin_amdgcn_kernarg_segment_ptr();
        asm volatile("" : "+s"(wv_), "+s"(bx), "+s"(ap));
        CArgs& args = *ap;
        if (ph >= args.ph_hi) break;
        const int tid = wv_ * 64 + lane_;
        unsigned char* ws = args.ws;
        const int lane = tid & 63, wave = __builtin_amdgcn_readfirstlane(tid >> 6);
        const int gw = bx * NWAVES + wave, NGW = G * NWAVES;
        if (ph == 0) { if (PHMASK & 1) phase_weights(args, lds, gw, NGW, wave, lane); }
        else if (ph == N_PHASES - 1) { if (PHMASK & 2) phase_norm(args, lds, DEPTH, gw, NGW, wave, lane); }
        else {
            const int l = (ph - 1) / 7, k = (ph - 1) % 7;
            const bf16* WIN = (const bf16*)(ws + WS_WIN) + (size_t)l * NPP * DMOD;
            const bf16* WA = (const bf16*)(ws + WS_WABO) + (size_t)l * 3 * DMOD * DMOD; const bf16* WB = WA + (size_t)DMOD * DMOD; const bf16* WO = WB + (size_t)DMOD * DMOD;
            if (k == 0) { if (PHMASK & 2) phase_norm(args, lds, l, gw, NGW, wave, lane); }
            else if (k == 1) { if (PHMASK & 4) {
                pg8::Gemm g{(const bf16*)(ws + WS_H), WIN, TOK, NPP, DMOD}; pg8::StaticOrder S; S.init(TOK, NPP, G, bx);
                pg8::EpiProj E{(bf16*)(ws + WS_P)};
                pg8::gemm_phase<pg8::EpiProj, pg8::StaticOrder, true, true>(lds, g, S, E, tid); }
            } else if (k == 2) {
                if (PHMASK & 8) for (int u = bx; u < 512; u += G) gla_intra_unit(args, l, lds, u >> 8, (u >> 2) & 63, u & 3, tid);
            } else if (k == 3) {
                if (PHMASK & 16) for (int u = bx; u < 128; u += G) gla_inter_unit(args, lds, u >> 4, u & 15, tid);
                if (PHMASK & 32) for (int L = bx; L < 2048; L += G) {
                    const int v = L & 255, i = L >> 8; const int bh = v >> 1, s = v & 1, jj = s + 2 * (i >> 1), qb = (i & 1) ? 15 - jj : jj;
                    const int b = bh >> 6, hh = bh & 63, h = hh >> 2, m = (hh >> 1) & 1, j = hh & 1;
                    const attn_body::bf16* Pp = (const attn_body::bf16*)(ws + WS_P);
                    attn_body::attn_unit<8>(b, qb, Pp + C_BQ + h * 128 + m * 64, Pp + C_BK + h * 128 + m * 64, Pp + C_BV + h * 128 + j * 64,
                                            (attn_body::bf16*)(ws + WS_OB) + (h * 2 + m) * 128 + j * 64, (char*)lds_raw, tid);
                }
            } else if (k == 4) { if (PHMASK & 64) phase_post(args, l, gw, NGW, lane); }
            else if (k == 5) { if (PHMASK & 128) {
                pg8::StaticOrder S; S.init(TOK, DMOD, G, bx);
                { pg8::Gemm g{(const bf16*)(ws + WS_OA), WA, TOK, DMOD, DMOD}; pg8::EpiGateA E{(const bf16*)(ws + WS_P), (float*)(ws + WS_T1)};
                  pg8::gemm_phase<pg8::EpiGateA, pg8::StaticOrder, true, true>(lds, g, S, E, tid); }
                { pg8::Gemm g{(const bf16*)(ws + WS_OBF), WB, TOK, DMOD, DMOD}; pg8::EpiGateB E{(const bf16*)(ws + WS_P), (const float*)(ws + WS_T1), (bf16*)(ws + WS_MG)};
                  pg8::gemm_phase<pg8::EpiGateB, pg8::StaticOrder, true, true>(lds, g, S, E, tid); } }
            } else if (PHMASK & 256) {
                pg8::Gemm g{(const bf16*)(ws + WS_MG), WO, TOK, DMOD, DMOD}; pg8::StaticOrder S; S.init(TOK, DMOD, G, bx);
                pg8::EpiOut E{(float*)(ws + WS_OUT), (float*)(ws + WS_PS)};
                pg8::gemm_phase<pg8::EpiOut, pg8::StaticOrder, true, true>(lds, g, S, E, tid);
            }
        }
        if (ph + 1 < args.ph_hi) { XcdBarrier b; b.bar = (unsigned*)(args.ws) + CW_BAR; b.x = xb_xcc_id(); b.st = (volatile LAS unsigned*)(lds + MISC_OFF) + 8; xcd_barrier(b, tid); }
    }
}

extern "C" void kernel_launch(void* const* d_in, const int* in_sizes, int n_in, void* d_out, int out_size, void* d_ws, size_t ws_size, hipStream_t stream) {
    static int grid = 0;
    if (grid == 0) {
        if (n_in != 12 || in_sizes[0] != TOK * DMOD || out_size != TOK * DMOD || ws_size < WS_END) { fprintf(stderr, "kernel_launch: unexpected shapes (n_in %d, in0 %d, out %d, ws %zu)\n", n_in, n_in > 0 ? in_sizes[0] : -1, out_size, ws_size); grid = -1; return; }
        int dev = 0, cus = 0, per_cu = 0;
        if (hipGetDevice(&dev) != hipSuccess || hipDeviceGetAttribute(&cus, hipDeviceAttributeMultiprocessorCount, dev) != hipSuccess) { grid = -1; return; }
        if (hipFuncSetAttribute((const void*)mega_fwd, hipFuncAttributeMaxDynamicSharedMemorySize, LDS_BYTES) != hipSuccess) { fprintf(stderr, "kernel_launch: hipFuncSetAttribute failed\n"); grid = -1; return; }
        if (hipOccupancyMaxActiveBlocksPerMultiprocessor(&per_cu, (const void*)mega_fwd, NTHR, LDS_BYTES) != hipSuccess || per_cu < 1) { fprintf(stderr, "kernel_launch: occupancy query says %d\n", per_cu); per_cu = 1; }
        (void)hipGetLastError();
        grid = cus;
    }
    if (grid < 0) return;
    if (hipMemsetAsync(d_ws, 0, CTL_ZERO_BYTES, stream) != hipSuccess) { fprintf(stderr, "kernel_launch: memset of the control words failed\n"); return; }
    Args a{};
    for (int i = 0; i < 12; ++i) a.in[i] = (const float*)d_in[i];
    a.out = (float*)d_out; a.ws = (unsigned char*)d_ws; a.ph_lo = 0; a.ph_hi = N_PHASES;
    void* kargs[] = {&a};
    hipError_t e = hipLaunchCooperativeKernel((const void*)mega_fwd, dim3(grid), dim3(NTHR), kargs, LDS_BYTES, stream);
    if (e != hipSuccess) fprintf(stderr, "kernel_launch: cooperative launch failed: %s (grid %d)\n", hipGetErrorString(e), grid);
}
```

```cpp
#include <hip/hip_runtime.h>
#include <hip/hip_cooperative_groups.h>
#include <cstdio>
#include <cstdint>
namespace pg8 {
#define PG8_LAS __attribute__((address_space(3)))
typedef unsigned short bf16_t;
typedef short bf16x8 __attribute__((ext_vector_type(8)));
typedef float f32x4 __attribute__((ext_vector_type(4)));
typedef unsigned u32x4 __attribute__((ext_vector_type(4)));
constexpr int BM = 256, BK = 64, HALF = 128, HTB = HALF * BK * 2  , STAGE_BYTES = 8 * HTB, NXCD = 8, WGM = 8;

__host__ __device__ __forceinline__ int lds_byte(int r, int c) { const int st = (r >> 4) * 2 + (c >> 5), rr = r & 15, cc = c & 31, ob = rr * 64 + cc * 2; return st * 1024 + (ob ^ (((ob >> 9) & 1) << 5)); }
__host__ __device__ __forceinline__ void stage_rc(int b, int& R, int& C) { const int st = b / 1024, sb = b % 1024, swz = sb ^ (((sb >> 9) & 1) << 5); R = (st >> 1) * 16 + swz / 64; C = (st & 1) * 32 + (swz % 64) / 2; }
__host__ __device__ __forceinline__ int perm32(int rho) { const int n = rho >> 4, i = rho & 15; return 8 * (i >> 2) + 4 * n + (i & 3); }

struct Unit { int pm, pn; };
struct Gemm { const bf16_t* A; const bf16_t* Bt; int M, N, K; };

struct StaticOrder {
    int nM, nN, nwg, G, c;
    __host__ __device__ void init(int M, int N, int G_, int c_) { nM = M / BM; nN = N / BM; nwg = nM * nN; G = G_; c = c_; }
    __host__ __device__ bool next(int i, Unit& u) const {
        const long L = (long)i * G + c; if (L >= nwg) return false;
        int wgid = (int)L; { const int q = nwg / NXCD, r = nwg % NXCD, xcd = wgid % NXCD, off = wgid / NXCD; wgid = (xcd < r ? xcd * (q + 1) : r * (q + 1) + (xcd - r) * q) + off; }
        const int nig = WGM * nN, gid = wgid / nig, fm = gid * WGM, gsz = (nM - fm) < WGM ? (nM - fm) : WGM;
        u.pm = fm + ((wgid % nig) % gsz); u.pn = (wgid % nig) / gsz; return true;
    }
    __device__ __forceinline__ void a_ready(const Unit&) const {}
    __device__ __forceinline__ void done(const Unit&) const {}
};

__device__ __forceinline__ unsigned cvt_pk_bf16(float lo, float hi) { unsigned r; asm volatile("v_cvt_pk_bf16_f32 %0, %1, %2" : "=v"(r) : "v"(lo), "v"(hi)); return r; }
constexpr int NP = 18432;
constexpr float QC2 = 0.125f * 1.4426950408889634f;
__device__ __forceinline__ float bflo(unsigned w) { return __uint_as_float(w << 16); }
__device__ __forceinline__ float bfhi(unsigned w) { return __uint_as_float(w & 0xffff0000u); }
__device__ __forceinline__ float sigm(float x) { return __builtin_amdgcn_rcpf(1.0f + __builtin_amdgcn_exp2f(-1.4426950408889634f * x)); }
struct EpiProj {
    static constexpr bool PERM = true, AFTER_DRAIN = false, HAS_MID = false;
    bf16_t* O;
    __device__ __forceinline__ void operator()(const f32x4 (&acc)[2][2][4][2], const Unit& u, int wr, int wc, int fr, int fq) const {
        const int row0 = u.pm * BM + wr * 64 + fr; const int colt = u.pn * BM;
        float sc = 1.f; if (colt < 1024) sc = 0.0625f; else if (colt >= 6144 && colt < 8192) sc = QC2;
        const int col0 = colt + wc * 32 + 8 * fq;
#pragma unroll
        for (int ai = 0; ai < 2; ++ai)
#pragma unroll
            for (int m = 0; m < 4; ++m) { bf16_t* rowp = O + (size_t)(row0 + ai * HALF + m * 16) * NP + col0;
#pragma unroll
                for (int bj = 0; bj < 2; ++bj) { const f32x4 v0 = acc[ai][bj][m][0] * sc, v1 = acc[ai][bj][m][1] * sc;
                    u32x4 w; w.x = cvt_pk_bf16(v0[0], v0[1]); w.y = cvt_pk_bf16(v0[2], v0[3]); w.z = cvt_pk_bf16(v1[0], v1[1]); w.w = cvt_pk_bf16(v1[2], v1[3]);
                    *(u32x4*)(rowp + bj * HALF) = w; } }
    }
};
struct EpiGateA {
    static constexpr bool PERM = true, AFTER_DRAIN = false, HAS_MID = false;
    const bf16_t* P; float* T1;
    __device__ __forceinline__ void operator()(const f32x4 (&acc)[2][2][4][2], const Unit& u, int wr, int wc, int fr, int fq) const {
        const int row0 = u.pm * BM + wr * 64 + fr; const int col0 = u.pn * BM + wc * 32 + 8 * fq;
#pragma unroll
        for (int ai = 0; ai < 2; ++ai)
#pragma unroll
            for (int m = 0; m < 4; ++m) { const size_t row = (size_t)(row0 + ai * HALF + m * 16);
#pragma unroll
                for (int bj = 0; bj < 2; ++bj) { const int col = col0 + bj * HALF;
                    const u32x4 g = *(const u32x4*)(P + row * NP + 14336 + col);
                    f32x4 o0, o1; const f32x4 a0 = acc[ai][bj][m][0], a1 = acc[ai][bj][m][1];
                    o0[0] = a0[0] * sigm(bflo(g.x)); o0[1] = a0[1] * sigm(bfhi(g.x)); o0[2] = a0[2] * sigm(bflo(g.y)); o0[3] = a0[3] * sigm(bfhi(g.y));
                    o1[0] = a1[0] * sigm(bflo(g.z)); o1[1] = a1[1] * sigm(bfhi(g.z)); o1[2] = a1[2] * sigm(bflo(g.w)); o1[3] = a1[3] * sigm(bfhi(g.w));
                    float* tp = T1 + row * 2048 + col; *(f32x4*)tp = o0; *(f32x4*)(tp + 4) = o1; } }
    }
};
struct EpiGateB {
    static constexpr bool PERM = true, AFTER_DRAIN = false, HAS_MID = false;
    const bf16_t* P; const float* T1; bf16_t* MG;
    __device__ __forceinline__ void operator()(const f32x4 (&acc)[2][2][4][2], const Unit& u, int wr, int wc, int fr, int fq) const {
        const int row0 = u.pm * BM + wr * 64 + fr; const int col0 = u.pn * BM + wc * 32 + 8 * fq;
#pragma unroll
        for (int ai = 0; ai < 2; ++ai)
#pragma unroll
            for (int m = 0; m < 4; ++m) { const size_t row = (size_t)(row0 + ai * HALF + m * 16);
#pragma unroll
                for (int bj = 0; bj < 2; ++bj) { const int col = col0 + bj * HALF;
                    const u32x4 g = *(const u32x4*)(P + row * NP + 16384 + col);
                    const float* tp = T1 + row * 2048 + col; const f32x4 t0 = *(const f32x4*)tp, t1 = *(const f32x4*)(tp + 4);
                    f32x4 o0, o1; const f32x4 a0 = acc[ai][bj][m][0], a1 = acc[ai][bj][m][1];
                    o0[0] = t0[0] + a0[0] * sigm(bflo(g.x)); o0[1] = t0[1] + a0[1] * sigm(bfhi(g.x)); o0[2] = t0[2] + a0[2] * sigm(bflo(g.y)); o0[3] = t0[3] + a0[3] * sigm(bfhi(g.y));
                    o1[0] = t1[0] + a1[0] * sigm(bflo(g.z)); o1[1] = t1[1] + a1[1] * sigm(bfhi(g.z)); o1[2] = t1[2] + a1[2] * sigm(bflo(g.w)); o1[3] = t1[3] + a1[3] * sigm(bfhi(g.w));
                    u32x4 w; w.x = cvt_pk_bf16(o0[0], o0[1]); w.y = cvt_pk_bf16(o0[2], o0[3]); w.z = cvt_pk_bf16(o1[0], o1[1]); w.w = cvt_pk_bf16(o1[2], o1[3]);
                    *(u32x4*)(MG + row * 2048 + col) = w; } }
    }
};
struct EpiOut {
    static constexpr bool PERM = true, AFTER_DRAIN = false, HAS_MID = false;
    bf16_t* OUT; float* PS;
    __device__ __forceinline__ void operator()(const f32x4 (&acc)[2][2][4][2], const Unit& u, int wr, int wc, int fr, int fq) const {
        const int row0 = u.pm * BM + wr * 64 + fr; const int col0 = u.pn * BM + wc * 32 + 8 * fq;
#pragma unroll
        for (int ai = 0; ai < 2; ++ai)
#pragma unroll
            for (int m = 0; m < 4; ++m) { const size_t row = (size_t)(row0 + ai * HALF + m * 16); float s = 0.f;
#pragma unroll
                for (int bj = 0; bj < 2; ++bj) { const f32x4 a0 = acc[ai][bj][m][0], a1 = acc[ai][bj][m][1];
                    { u32x4 w; w.x = cvt_pk_bf16(a0[0], a0[1]); w.y = cvt_pk_bf16(a0[2], a0[3]); w.z = cvt_pk_bf16(a1[0], a1[1]); w.w = cvt_pk_bf16(a1[2], a1[3]); *(u32x4*)(OUT + row * 2048 + col0 + bj * HALF) = w; }
                    s += (a0[0] * a0[0] + a0[1] * a0[1]) + (a0[2] * a0[2] + a0[3] * a0[3]) + (a1[0] * a1[0] + a1[1] * a1[1]) + (a1[2] * a1[2] + a1[3] * a1[3]); }
                s += __uint_as_float(__builtin_amdgcn_ds_bpermute((((fq ^ 1) << 4) | fr) << 2, __float_as_uint(s))); s += __uint_as_float(__builtin_amdgcn_ds_bpermute((((fq ^ 2) << 4) | fr) << 2, __float_as_uint(s)));
                if (fq == 0) PS[row * 32 + u.pn * 4 + wc] = s; }
    }
};
struct EpiMerge {
    static constexpr bool PERM = true, AFTER_DRAIN = false, HAS_MID = true;
    const bf16_t* P; bf16_t* MG;
    __device__ __forceinline__ void mid(f32x4 (&acc)[2][2][4][2], const Unit& u, int wr, int wc, int fr, int fq) const {
        int row0 = u.pm * BM + wr * 64 + fr; int col0 = u.pn * BM + wc * 32 + 8 * fq;
        asm volatile("" : "+v"(row0), "+v"(col0));
#define RT_(x, y) ((1.0f + __builtin_amdgcn_exp2f(-1.4426950408889634f * (y))) * __builtin_amdgcn_rcpf(1.0f + __builtin_amdgcn_exp2f(-1.4426950408889634f * (x))))
#pragma unroll
        for (int ai = 0; ai < 2; ++ai)
#pragma unroll
            for (int mp = 0; mp < 4; mp += 2) {
                u32x4 ga[2][2], gb[2][2];
#pragma unroll
                for (int mm = 0; mm < 2; ++mm)
#pragma unroll
                    for (int bj = 0; bj < 2; ++bj) { const size_t row = (size_t)(row0 + ai * HALF + (mp + mm) * 16); const int col = col0 + bj * HALF;
                        ga[mm][bj] = *(const u32x4*)(P + row * NP + 14336 + col); gb[mm][bj] = *(const u32x4*)(P + row * NP + 16384 + col); }
#pragma unroll
                for (int mm = 0; mm < 2; ++mm)
#pragma unroll
                    for (int bj = 0; bj < 2; ++bj) { const int m = mp + mm; const u32x4 xa = ga[mm][bj], xb = gb[mm][bj];
                        f32x4 a0 = acc[ai][bj][m][0], a1 = acc[ai][bj][m][1];
                        a0[0] *= RT_(bflo(xa.x), bflo(xb.x)); a0[1] *= RT_(bfhi(xa.x), bfhi(xb.x)); a0[2] *= RT_(bflo(xa.y), bflo(xb.y)); a0[3] *= RT_(bfhi(xa.y), bfhi(xb.y));
                        a1[0] *= RT_(bflo(xa.z), bflo(xb.z)); a1[1] *= RT_(bfhi(xa.z), bfhi(xb.z)); a1[2] *= RT_(bflo(xa.w), bflo(xb.w)); a1[3] *= RT_(bfhi(xa.w), bfhi(xb.w));
                        acc[ai][bj][m][0] = a0; acc[ai][bj][m][1] = a1; }
                asm volatile("" ::: "memory"); }
#undef RT_
    }
    __device__ __forceinline__ void operator()(const f32x4 (&acc)[2][2][4][2], const Unit& u, int wr, int wc, int fr, int fq) const {
        const int row0 = u.pm * BM + wr * 64 + fr; const int col0 = u.pn * BM + wc * 32 + 8 * fq;
#pragma unroll
        for (int ai = 0; ai < 2; ++ai) {
            u32x4 gv[4][2];
#pragma unroll
            for (int m = 0; m < 4; ++m)
#pragma unroll
                for (int bj = 0; bj < 2; ++bj) gv[m][bj] = *(const u32x4*)(P + (size_t)(row0 + ai * HALF + m * 16) * NP + 16384 + col0 + bj * HALF);
#pragma unroll
            for (int m = 0; m < 4; ++m) { const size_t row = (size_t)(row0 + ai * HALF + m * 16);
#pragma unroll
                for (int bj = 0; bj < 2; ++bj) { const int col = col0 + bj * HALF; const u32x4 g = gv[m][bj];
                    const f32x4 a0 = acc[ai][bj][m][0], a1 = acc[ai][bj][m][1];
                    u32x4 w; w.x = cvt_pk_bf16(a0[0] * sigm(bflo(g.x)), a0[1] * sigm(bfhi(g.x))); w.y = cvt_pk_bf16(a0[2] * sigm(bflo(g.y)), a0[3] * sigm(bfhi(g.y)));
                    w.z = cvt_pk_bf16(a1[0] * sigm(bflo(g.z)), a1[1] * sigm(bfhi(g.z))); w.w = cvt_pk_bf16(a1[2] * sigm(bflo(g.w)), a1[3] * sigm(bfhi(g.w)));
                    *(u32x4*)(MG + row * 2048 + col) = w; } }
            asm volatile("" ::: "memory"); }
    }
};
struct RowStats {
    float* xbuf;
    unsigned* cnt;
    __device__ __forceinline__ void run(const f32x4 (&v)[2][2][4][2], const Unit& u, int wr, int wc, int fr, int fq, PG8_LAS unsigned char* lds, int wid, int lane) const {
        PG8_LAS float* Pp = (PG8_LAS float*)lds;
        PG8_LAS float* S = (PG8_LAS float*)(lds + 4096);
#pragma unroll
        for (int ai = 0; ai < 2; ++ai)
#pragma unroll
            for (int m = 0; m < 4; ++m) {
                float s = 0.f;
#pragma unroll
                for (int bj = 0; bj < 2; ++bj)
#pragma unroll
                    for (int n = 0; n < 2; ++n) { const f32x4 x = v[ai][bj][m][n]; s += (x[0] * x[0] + x[1] * x[1]) + (x[2] * x[2] + x[3] * x[3]); }
                s += __uint_as_float(__builtin_amdgcn_ds_bpermute((((fq ^ 1) << 4) | fr) << 2, __float_as_uint(s)));
                s += __uint_as_float(__builtin_amdgcn_ds_bpermute((((fq ^ 2) << 4) | fr) << 2, __float_as_uint(s)));
                if (fq == 0) Pp[(ai * HALF + wr * 64 + m * 16 + fr) * 4 + wc] = s;
            }
        asm volatile("s_waitcnt lgkmcnt(0)" ::: "memory"); __builtin_amdgcn_s_barrier(); asm volatile("" ::: "memory");
        const int row = wid * 32 + (lane & 31);
        if (lane < 32) {
            const float tot = (Pp[row * 4 + 0] + Pp[row * 4 + 1]) + (Pp[row * 4 + 2] + Pp[row * 4 + 3]);
            __hip_atomic_store(xbuf + (size_t)(u.pm * BM + row) * 8 + u.pn, tot, __ATOMIC_RELAXED, __HIP_MEMORY_SCOPE_AGENT);
        }
        asm volatile("s_waitcnt vmcnt(0)" ::: "memory");
        if (lane == 0) __hip_atomic_fetch_add(cnt, 1u, __ATOMIC_RELAXED, __HIP_MEMORY_SCOPE_AGENT);
        if (wid == 0) {
            while ((unsigned)__builtin_amdgcn_readfirstlane(__hip_atomic_load(cnt, __ATOMIC_RELAXED, __HIP_MEMORY_SCOPE_AGENT)) < 64u) __builtin_amdgcn_s_sleep(2);
            __builtin_amdgcn_fence(__ATOMIC_ACQUIRE, "agent");
        }
        asm volatile("s_waitcnt vmcnt(0) lgkmcnt(0)" ::: "memory"); __builtin_amdgcn_s_barrier(); asm volatile("" ::: "memory");
        if (lane < 32) {
            const float* slot = xbuf + (size_t)(u.pm * BM + row) * 8;
            float v8[8];
#pragma unroll
            for (int t = 0; t < 8; ++t) v8[t] = __hip_atomic_load(slot + t, __ATOMIC_RELAXED, __HIP_MEMORY_SCOPE_AGENT);
            const float q = ((v8[0] + v8[1]) + (v8[2] + v8[3])) + ((v8[4] + v8[5]) + (v8[6] + v8[7]));
            S[row] = 1.0f / sqrtf(q * (1.0f / 2048.0f) + 1e-6f);
        }
        asm volatile("s_waitcnt lgkmcnt(0)" ::: "memory"); __builtin_amdgcn_s_barrier(); asm volatile("" ::: "memory");
    }
};
template <bool XIN_BF, bool XOUT_BF> struct EpiOutFusedT {
    static constexpr bool PERM = true, AFTER_DRAIN = true, HAS_MID = false;
    const void* xprev; void* xout; bf16_t* H; const float* gpost; const float* gpre; RowStats st1, st2; int last;
    __device__ __forceinline__ void fused(f32x4 (&acc)[2][2][4][2], const Unit& u, int wr, int wc, int fr, int fq, PG8_LAS unsigned char* lds, int wid, int lane) const {
        const PG8_LAS float* S = (const PG8_LAS float*)(lds + 4096);
        const int col0 = u.pn * BM + wc * 32 + 8 * fq;
        const float* xpf = (const float*)xprev; const bf16_t* xpb = (const bf16_t*)xprev; float* xof = (float*)xout; bf16_t* xob = (bf16_t*)xout;
        f32x4 pre[XIN_BF ? 1 : 4][2][2]; u32x4 preb[XIN_BF ? 4 : 1][2];
#pragma unroll
        for (int m = 0; m < 4; ++m) { const size_t off = (size_t)(u.pm * BM + wr * 64 + m * 16 + fr) * 2048 + col0;
#pragma unroll
            for (int bj = 0; bj < 2; ++bj) {
                if constexpr (XIN_BF) preb[m][bj] = *(const u32x4*)(xpb + off + bj * HALF);
                else { pre[m][bj][0] = *(const f32x4*)(xpf + off + bj * HALF); pre[m][bj][1] = *(const f32x4*)(xpf + off + bj * HALF + 4); } } }
        st1.run(acc, u, wr, wc, fr, fq, lds, wid, lane);
        {
            f32x4 g[2][2];
#pragma unroll
            for (int bj = 0; bj < 2; ++bj) { g[bj][0] = *(const f32x4*)(gpost + col0 + bj * HALF); g[bj][1] = *(const f32x4*)(gpost + col0 + bj * HALF + 4); }
#pragma unroll
            for (int ai = 0; ai < 2; ++ai) {
                if (ai == 1) {
#pragma unroll
                    for (int m = 0; m < 4; ++m) { const size_t off = (size_t)(u.pm * BM + HALF + wr * 64 + m * 16 + fr) * 2048 + col0;
#pragma unroll
                        for (int bj = 0; bj < 2; ++bj) {
                            if constexpr (XIN_BF) preb[m][bj] = *(const u32x4*)(xpb + off + bj * HALF);
                            else { pre[m][bj][0] = *(const f32x4*)(xpf + off + bj * HALF); pre[m][bj][1] = *(const f32x4*)(xpf + off + bj * HALF + 4); } } }
                }
#pragma unroll
                for (int m = 0; m < 4; ++m) { const int r = ai * HALF + wr * 64 + m * 16 + fr; const float rs = S[r]; const size_t off = (size_t)(u.pm * BM + r) * 2048 + col0;
#pragma unroll
                    for (int bj = 0; bj < 2; ++bj) {
                        f32x4 b0, b1;
                        if constexpr (XIN_BF) { const u32x4 w = preb[m][bj]; b0 = (f32x4){bflo(w.x), bfhi(w.x), bflo(w.y), bfhi(w.y)}; b1 = (f32x4){bflo(w.z), bfhi(w.z), bflo(w.w), bfhi(w.w)}; }
                        else { b0 = pre[m][bj][0]; b1 = pre[m][bj][1]; }
                        const f32x4 x0 = b0 + acc[ai][bj][m][0] * rs * g[bj][0], x1 = b1 + acc[ai][bj][m][1] * rs * g[bj][1];
                        acc[ai][bj][m][0] = x0; acc[ai][bj][m][1] = x1;
                        if constexpr (XOUT_BF) { u32x4 w; w.x = cvt_pk_bf16(x0[0], x0[1]); w.y = cvt_pk_bf16(x0[2], x0[3]); w.z = cvt_pk_bf16(x1[0], x1[1]); w.w = cvt_pk_bf16(x1[2], x1[3]); *(u32x4*)(xob + off + bj * HALF) = w; }
                        else { *(f32x4*)(xof + off + bj * HALF) = x0; *(f32x4*)(xof + off + bj * HALF + 4) = x1; } }
                    asm volatile("" : "+v"(acc[ai][0][m][0]), "+v"(acc[ai][0][m][1]), "+v"(acc[ai][1][m][0]), "+v"(acc[ai][1][m][1])); }
                asm volatile("" ::: "memory");
            }
        }
        if (last) return;
        asm volatile("s_waitcnt lgkmcnt(0)" ::: "memory"); __builtin_amdgcn_s_barrier(); asm volatile("" ::: "memory");
        st2.run(acc, u, wr, wc, fr, fq, lds, wid, lane);
        {
            f32x4 g[2][2];
#pragma unroll
            for (int bj = 0; bj < 2; ++bj) { g[bj][0] = *(const f32x4*)(gpre + col0 + bj * HALF); g[bj][1] = *(const f32x4*)(gpre + col0 + bj * HALF + 4); }
#pragma unroll
            for (int ai = 0; ai < 2; ++ai)
#pragma unroll
                for (int m = 0; m < 4; ++m) { const int r = ai * HALF + wr * 64 + m * 16 + fr; const float rs = S[r]; const size_t off = (size_t)(u.pm * BM + r) * 2048 + col0;
#pragma unroll
                    for (int bj = 0; bj < 2; ++bj) { const f32x4 h0 = acc[ai][bj][m][0] * rs * g[bj][0], h1 = acc[ai][bj][m][1] * rs * g[bj][1];
                        u32x4 w; w.x = cvt_pk_bf16(h0[0], h0[1]); w.y = cvt_pk_bf16(h0[2], h0[3]); w.z = cvt_pk_bf16(h1[0], h1[1]); w.w = cvt_pk_bf16(h1[2], h1[3]);
                        *(u32x4*)(H + off + bj * HALF) = w; } }
        }
    }
};
template <class Epi, class Sched, bool ALIGN_EPI = false, bool SP2 = false>
__device__ __forceinline__ void gemm_phase(PG8_LAS unsigned char* lds, const Gemm g, const Sched& S, const Epi& E, const int tid) {
    const int wid = __builtin_amdgcn_readfirstlane(tid >> 6), lane = tid & 63, wr = wid >> 2, wc = wid & 3, fr = lane & 15, fq = lane >> 4;
    const int K = g.K, nt = K / BK;
    unsigned voffA[2], voffB[2];
#pragma unroll
    for (int i = 0; i < 2; ++i) { int R, C; stage_rc(tid * 16 + i * 8192, R, C); const int Rb = Epi::PERM ? ((R & ~31) + perm32(R & 31)) : R;
        voffA[i] = (unsigned)(R * K + C) * 2u; voffB[i] = (unsigned)(Rb * K + C) * 2u; }
    const size_t kstep = (size_t)(BK * 2);
    const size_t hstep = (size_t)HALF * K * 2;
    const size_t tstep = 2 * hstep;
    const unsigned ldsw = (unsigned)wid * 1024u;
    const int aoff = lds_byte(wr * 64 + fr, fq * 8), boff = lds_byte(wc * 32 + fr, fq * 8);
#define PG8_SA(b, h) (((b) * 2 + (h)) * HTB)
#define PG8_SB(b, h) ((4 + (b) * 2 + (h)) * HTB)
#define PG8_STAGE(bufoff, gbase, voff) do { _Pragma("unroll") for (int _i = 0; _i < 2; ++_i) \
        __builtin_amdgcn_global_load_lds((const unsigned*)((const char*)(gbase) + (voff)[_i]), (PG8_LAS unsigned*)(lds + (bufoff) + ldsw + _i * 8192), 16, 0, 0); } while (0)
#define PG8_LDA(dst, b, h) do { _Pragma("unroll") for (int m = 0; m < 4; ++m) _Pragma("unroll") for (int k = 0; k < 2; ++k) dst[m][k] = *(const PG8_LAS bf16x8*)(lds + PG8_SA(b, h) + aoff + m * 2048 + k * 1024); } while (0)
#define PG8_LDB(dst, b, h) do { _Pragma("unroll") for (int n = 0; n < 2; ++n) _Pragma("unroll") for (int k = 0; k < 2; ++k) dst[n][k] = *(const PG8_LAS bf16x8*)(lds + PG8_SB(b, h) + boff + n * 2048 + k * 1024); } while (0)
#define PG8_MMA(ai, bj, At, Bt) do { __builtin_amdgcn_s_setprio(1); _Pragma("unroll") for (int m = 0; m < 4; ++m) _Pragma("unroll") for (int n = 0; n < 2; ++n) _Pragma("unroll") for (int k = 0; k < 2; ++k) \
        acc[ai][bj][m][n] = __builtin_amdgcn_mfma_f32_16x16x32_bf16(Bt[n][k], At[m][k], acc[ai][bj][m][n], 0, 0, 0); __builtin_amdgcn_s_setprio(0); } while (0)
#define PG8_WAIT_V(n) asm volatile("s_waitcnt vmcnt(" #n ")" ::: "memory")
#define PG8_WAIT_L(n) asm volatile("s_waitcnt lgkmcnt(" #n ")" ::: "memory")
#define PG8_BAR __builtin_amdgcn_s_barrier()
#define PG8_SCHED __builtin_amdgcn_sched_barrier(0)
    Unit cur, nxt; int ui = 0;
    if (!S.next(0, cur)) return;
    f32x4 acc[2][2][4][2];
#pragma unroll
    for (int a = 0; a < 2; ++a)
#pragma unroll
        for (int b = 0; b < 2; ++b)
#pragma unroll
            for (int m = 0; m < 4; ++m)
#pragma unroll
                for (int n = 0; n < 2; ++n) acc[a][b][m][n] = (f32x4){0.f, 0.f, 0.f, 0.f};
    bf16x8 At[4][2], B0[2][2], B1[2][2];
    const char* cA = (const char*)g.A + (size_t)cur.pm * tstep; const char* cB = (const char*)g.Bt + (size_t)cur.pn * tstep;
    S.a_ready(cur);
    if constexpr (SP2) {
        PG8_STAGE(PG8_SB(0, 0), cB, voffB); PG8_STAGE(PG8_SB(0, 1), cB + hstep, voffB); PG8_STAGE(PG8_SA(0, 0), cA, voffA); PG8_STAGE(PG8_SA(0, 1), cA + hstep, voffA);
        if (wr == 1) PG8_BAR;
        PG8_WAIT_V(2); PG8_BAR;
        PG8_STAGE(PG8_SB(1, 0), cB + kstep, voffB); PG8_STAGE(PG8_SA(1, 0), cA + kstep, voffA); PG8_STAGE(PG8_SB(1, 1), cB + hstep + kstep, voffB);
        PG8_WAIT_V(6); PG8_BAR;
    } else {
        PG8_STAGE(PG8_SB(0, 0), cB, voffB); PG8_STAGE(PG8_SA(0, 0), cA, voffA); PG8_STAGE(PG8_SB(0, 1), cB + hstep, voffB); PG8_STAGE(PG8_SA(0, 1), cA + hstep, voffA);
        if (wr == 1) PG8_BAR;
        PG8_WAIT_V(4); PG8_BAR;
        PG8_STAGE(PG8_SB(1, 0), cB + kstep, voffB); PG8_STAGE(PG8_SA(1, 0), cA + kstep, voffA); PG8_STAGE(PG8_SB(1, 1), cB + hstep + kstep, voffB);
        PG8_WAIT_V(6); PG8_BAR;
    }
    for (;;) {
        const bool has_next = S.next(ui + 1, nxt);
        const char* nA = has_next ? (const char*)g.A + (size_t)nxt.pm * tstep : cA; const char* nB = has_next ? (const char*)g.Bt + (size_t)nxt.pn * tstep : cB;
        for (int t = 0; t < nt; t += 2) {
            if constexpr (Epi::HAS_MID) { if (t == (nt >> 1)) E.mid(acc, cur, wr, wc, fr, fq); }
            const bool last = (t == nt - 2);
            const char* a1 = cA + (size_t)(t + 1) * kstep;
            const char* a2 = last ? nA : cA + (size_t)(t + 2) * kstep; const char* b2 = last ? nB : cB + (size_t)(t + 2) * kstep;
            const char* a3 = a2 + kstep; const char* b3 = b2 + kstep;
            if (last && has_next) S.a_ready(nxt);
            if constexpr (SP2) {
            PG8_LDB(B0, 0, 0); PG8_LDB(B1, 0, 1); PG8_SCHED; PG8_LDA(At, 0, 0); PG8_STAGE(PG8_SA(1, 1), a1 + hstep, voffA);
            PG8_WAIT_V(8); PG8_WAIT_L(0); PG8_BAR; PG8_MMA(0, 0, At, B0); PG8_MMA(0, 1, At, B1); PG8_BAR; PG8_SCHED;
            PG8_LDA(At, 0, 1); PG8_STAGE(PG8_SB(0, 0), b2, voffB); PG8_STAGE(PG8_SB(0, 1), b2 + hstep, voffB); PG8_STAGE(PG8_SA(0, 0), a2, voffA);
            PG8_WAIT_V(8); PG8_WAIT_L(0); PG8_BAR; PG8_MMA(1, 0, At, B0); PG8_MMA(1, 1, At, B1); PG8_BAR; PG8_SCHED;
            PG8_LDB(B0, 1, 0); PG8_LDB(B1, 1, 1); PG8_SCHED; PG8_LDA(At, 1, 0); PG8_STAGE(PG8_SA(0, 1), a2 + hstep, voffA);
            PG8_WAIT_V(8); PG8_WAIT_L(0); PG8_BAR; PG8_MMA(0, 0, At, B0); PG8_MMA(0, 1, At, B1); PG8_BAR; PG8_SCHED;
            PG8_LDA(At, 1, 1); PG8_STAGE(PG8_SB(1, 0), b3, voffB); PG8_STAGE(PG8_SB(1, 1), b3 + hstep, voffB); PG8_STAGE(PG8_SA(1, 0), a3, voffA);
            PG8_WAIT_V(8); PG8_WAIT_L(0); PG8_BAR; PG8_MMA(1, 0, At, B0); PG8_MMA(1, 1, At, B1); PG8_BAR; PG8_SCHED;
            } else {
            PG8_LDB(B0, 0, 0); PG8_SCHED; PG8_LDA(At, 0, 0); PG8_STAGE(PG8_SA(1, 1), a1 + hstep, voffA);
            PG8_WAIT_L(8); PG8_BAR; PG8_WAIT_L(0); PG8_MMA(0, 0, At, B0); PG8_BAR; PG8_SCHED;
            PG8_LDB(B1, 0, 1); PG8_STAGE(PG8_SB(0, 0), b2, voffB);
            PG8_BAR; PG8_WAIT_L(0); PG8_MMA(0, 1, At, B1); PG8_BAR;
            PG8_LDA(At, 0, 1); PG8_STAGE(PG8_SA(0, 0), a2, voffA);
            PG8_BAR; PG8_WAIT_L(0); PG8_MMA(1, 0, At, B0); PG8_BAR; PG8_SCHED;
            PG8_STAGE(PG8_SB(0, 1), b2 + hstep, voffB);
            PG8_WAIT_V(6); PG8_BAR; PG8_MMA(1, 1, At, B1); PG8_BAR;
            PG8_LDB(B0, 1, 0); PG8_SCHED; PG8_LDA(At, 1, 0); PG8_STAGE(PG8_SA(0, 1), a2 + hstep, voffA);
            PG8_WAIT_L(8); PG8_BAR; PG8_WAIT_L(0); PG8_MMA(0, 0, At, B0); PG8_BAR; PG8_SCHED;
            PG8_LDB(B1, 1, 1); PG8_STAGE(PG8_SB(1, 0), b3, voffB);
            PG8_BAR; PG8_WAIT_L(0); PG8_MMA(0, 1, At, B1); PG8_BAR;
            PG8_LDA(At, 1, 1); PG8_STAGE(PG8_SA(1, 0), a3, voffA);
            PG8_BAR; PG8_WAIT_L(0); PG8_MMA(1, 0, At, B0); PG8_BAR; PG8_SCHED;
            PG8_STAGE(PG8_SB(1, 1), b3 + hstep, voffB);
            PG8_WAIT_V(6); PG8_BAR; PG8_MMA(1, 1, At, B1); PG8_BAR;
            }
        }
        if constexpr (ALIGN_EPI) { if (wr == 0) PG8_BAR; }
        if constexpr (!Epi::AFTER_DRAIN) { E(acc, cur, wr, wc, fr, fq); S.done(cur); }
        if (!has_next) break;
#pragma unroll
        for (int a = 0; a < 2; ++a)
#pragma unroll
            for (int b = 0; b < 2; ++b)
#pragma unroll
                for (int m = 0; m < 4; ++m)
#pragma unroll
                    for (int n = 0; n < 2; ++n) acc[a][b][m][n] = (f32x4){0.f, 0.f, 0.f, 0.f};
        cur = nxt; cA = nA; cB = nB; ++ui;
        if constexpr (ALIGN_EPI) { if (wr == 1) PG8_BAR; }
    }
    PG8_WAIT_V(0);
    if constexpr (!ALIGN_EPI) { if (wr == 0) PG8_BAR; }
    PG8_BAR;
    if constexpr (Epi::AFTER_DRAIN) { E.fused(acc, cur, wr, wc, fr, fq, lds, wid, lane); S.done(cur); }
#undef PG8_SA
#undef PG8_SB
#undef PG8_STAGE
#undef PG8_LDA
#undef PG8_LDB
#undef PG8_MMA
#undef PG8_WAIT_V
#undef PG8_WAIT_L
#undef PG8_BAR
#undef PG8_SCHED
}
}
#include <hip/hip_bf16.h>
#include <cmath>
namespace attn_body {
using bf16=__hip_bfloat16;
using bf16x8=__attribute__((ext_vector_type(8)))short;
using s16x4=__attribute__((ext_vector_type(4)))short;
using f32x16=__attribute__((ext_vector_type(16)))float;
using u32x4=__attribute__((ext_vector_type(4)))unsigned;
constexpr int BATCH=2,SEQ=4096,D=64,DM=18432,DMO=4096;
constexpr int NW=8,QBLK=32,QB=QBLK*NW,KVBLK=64,NQB=SEQ/QB;
constexpr int ATTN_PITCH=DM, ATTN_UNIT_ROWS=QB;
__device__ __forceinline__ int crow(int r,int hi){return (r&3)+8*(r>>2)+4*hi;}
#define SBAR() __builtin_amdgcn_sched_barrier(0)
__device__ __forceinline__ void cmask(f32x16&p0,f32x16&p1,int jb,int qrel,int hi){
  const float NEG=-INFINITY; int kb=64*jb+4*hi;
  #pragma unroll
  for(int r=0;r<16;++r){int kv=kb+(r&3)+8*(r>>2); if(kv>qrel)p0[r]=NEG; if(kv+32>qrel)p1[r]=NEG;}
}

constexpr int NSLOT=3, SLOTB=8192;
constexpr int LDS_K=0, LDS_V=NSLOT*SLOTB, LDS_WS=LDS_V+NSLOT*2*SLOTB, LDS_OST=LDS_WS+NW*64*4, LDS_BYTES=LDS_OST+NW*8192;
constexpr float C2=0.125f*1.4426950408889634f;
__device__ __forceinline__ void glds16(const void*gsrc,unsigned lds_dst){unsigned keep;
  asm volatile("s_mov_b32 %0, m0\n\ts_mov_b32 m0, %2\n\ts_nop 0\n\tglobal_load_lds_dwordx4 %1, off\n\ts_mov_b32 m0, %0":"=&s"(keep):"v"(gsrc),"s"(lds_dst):"memory");}
__device__ __forceinline__ float max3f(float a,float b,float c){float r;asm("v_max3_f32 %0, %1, %2, %3":"=v"(r):"v"(a),"v"(b),"v"(c));return r;}
__device__ __forceinline__ float max2f(float a,float b){float r;asm("v_max_f32_e32 %0, %1, %2":"=v"(r):"v"(a),"v"(b));return r;}
__device__ __forceinline__ float fadd_s(float a,float b){float r;asm("v_add_f32_e32 %0, %1, %2":"=v"(r):"v"(a),"v"(b));return r;}
__device__ __forceinline__ float fsub_s(float a,float b){float r;asm("v_sub_f32_e32 %0, %1, %2":"=v"(r):"v"(a),"v"(b));return r;}
typedef float f32x2_t __attribute__((ext_vector_type(2))); typedef __bf16 bf16x2_t __attribute__((ext_vector_type(2)));
__device__ __forceinline__ unsigned cvtpk_s(float lo,float hi){f32x2_t v={lo,hi};bf16x2_t b=__builtin_convertvector(v,bf16x2_t);return __builtin_bit_cast(unsigned,b);}
#define WAIT_BAR(N) asm volatile("s_waitcnt vmcnt(" #N ") lgkmcnt(0)\n\ts_barrier":::"memory")

__device__ __forceinline__ void qkt(f32x16&p0,f32x16&p1,const char*Kslot,const bf16x8*qr,const f32x16&negm,int r32,int hi){
  const char*kb=Kslot+hi*1024+r32*16;
  #pragma unroll
  for(int d0=0;d0<4;++d0){
    const bf16x8 b0=*reinterpret_cast<const bf16x8*>(kb+d0*2048);
    const bf16x8 b1=*reinterpret_cast<const bf16x8*>(kb+d0*2048+512);
    if(d0==0){p0=__builtin_amdgcn_mfma_f32_32x32x16_bf16(b0,qr[0],negm,0,0,0);p1=__builtin_amdgcn_mfma_f32_32x32x16_bf16(b1,qr[0],negm,0,0,0);}
    else{p0=__builtin_amdgcn_mfma_f32_32x32x16_bf16(b0,qr[d0],p0,0,0,0);p1=__builtin_amdgcn_mfma_f32_32x32x16_bf16(b1,qr[d0],p1,0,0,0);}}
}
typedef __attribute__((address_space(3))) const char* lds_cptr;
typedef short v4i16_t __attribute__((ext_vector_type(4)));
__device__ __forceinline__ void kload8(bf16x8*kf,lds_cptr kp){
  kf[0]=*(const __attribute__((address_space(3))) bf16x8*)(kp);      kf[1]=*(const __attribute__((address_space(3))) bf16x8*)(kp+512);
  kf[2]=*(const __attribute__((address_space(3))) bf16x8*)(kp+2048); kf[3]=*(const __attribute__((address_space(3))) bf16x8*)(kp+2560);
  kf[4]=*(const __attribute__((address_space(3))) bf16x8*)(kp+4096); kf[5]=*(const __attribute__((address_space(3))) bf16x8*)(kp+4608);
  kf[6]=*(const __attribute__((address_space(3))) bf16x8*)(kp+6144); kf[7]=*(const __attribute__((address_space(3))) bf16x8*)(kp+6656);
}
__device__ __forceinline__ void kload2(bf16x8*kf,lds_cptr kp,int j){ kf[2*j]=*(const __attribute__((address_space(3))) bf16x8*)(kp+j*2048); kf[2*j+1]=*(const __attribute__((address_space(3))) bf16x8*)(kp+j*2048+512); }
__device__ __forceinline__ s16x4 vtr(lds_cptr p){ return __builtin_bit_cast(s16x4,__builtin_amdgcn_ds_read_tr16_b64_v4i16((__attribute__((address_space(3))) v4i16_t*)p)); }
__device__ __forceinline__ float rowmax(const f32x16&p0,const f32x16&p1){
  float a=max3f(p0[0],p0[1],p1[0]),b=max3f(p0[2],p0[3],p1[1]);a=max3f(a,p1[2],p1[3]);
  #pragma unroll
  for(int r=4;r<16;r+=4){a=max3f(a,p0[r],p0[r+1]);b=max3f(b,p0[r+2],p0[r+3]);a=max3f(a,p1[r],p1[r+1]);b=max3f(b,p1[r+2],p1[r+3]);}
  const float m=max2f(a,b);
  auto rr=__builtin_amdgcn_permlane32_swap(__float_as_uint(m),__float_as_uint(m),false,false);
  return max2f(__uint_as_float(rr[0]),__uint_as_float(rr[1]));
}
__device__ __forceinline__ void pv(f32x16*o,int vb,bf16x8 pa0,bf16x8 pa1,bf16x8 pa2,bf16x8 pa3){
  #pragma unroll
  for(int d0=0;d0<4;++d0){s16x4 lo[4],hi[4];
    #pragma unroll
    for(int ks=0;ks<4;++ks){
      asm volatile("ds_read_b64_tr_b16 %0,%1 offset:%c2":"=&v"(lo[ks]):"v"(vb),"i"(d0*4096+ks*1024):"memory");
      asm volatile("ds_read_b64_tr_b16 %0,%1 offset:%c2":"=&v"(hi[ks]):"v"(vb),"i"(d0*4096+ks*1024+512):"memory");}
    asm volatile("s_waitcnt lgkmcnt(0)":::"memory");SBAR();
    #define PK(k) (bf16x8){lo[k][0],lo[k][1],lo[k][2],lo[k][3],hi[k][0],hi[k][1],hi[k][2],hi[k][3]}
    o[d0]=__builtin_amdgcn_mfma_f32_32x32x16_bf16(pa0,PK(0),o[d0],0,0,0);
    o[d0]=__builtin_amdgcn_mfma_f32_32x32x16_bf16(pa1,PK(1),o[d0],0,0,0);
    o[d0]=__builtin_amdgcn_mfma_f32_32x32x16_bf16(pa2,PK(2),o[d0],0,0,0);
    o[d0]=__builtin_amdgcn_mfma_f32_32x32x16_bf16(pa3,PK(3),o[d0],0,0,0);
    #undef PK
  }
}

#ifndef ATTN_STORE16
#define ATTN_STORE16(p,v) (*(u32x4*)(p)=(v))
#endif
template<int THRL> __device__ __forceinline__ void attn_unit(int b,int qb,const bf16*Q,const bf16*__restrict__ K,const bf16*__restrict__ V,bf16*O,char*shm,const int tid,const int mode,const float lam,const float oml,const bf16*BG,const float*dng,bf16*O2p){
  const int lane=tid&63,r32=lane&31,hi=lane>>5; const int wid=__builtin_amdgcn_readfirstlane(tid>>6);
  const long rowbase=(long)b*SEQ; const int q0=qb*QB;
  const bf16*Qw=Q+(rowbase+q0+wid*QBLK)*DM;
  const bf16*Kh=K+rowbase*DM,*Vh=V+rowbase*DM;
  const unsigned lds0=(unsigned)(uintptr_t)shm;
  float*wsf=(float*)(shm+LDS_WS)+wid*64;
  const bf16*ksrc=Kh+(long)lane*DM+wid*8;
  const bf16*vsrc=Vh+(long)(16*(wid&3)+(lane>>2))*DM+(wid>>2)*32+(lane&3)*8;
  const unsigned kdst=lds0+LDS_K+wid*1024, vdst=lds0+LDS_V+wid*1024;
  #define DMA_K(t,slot) glds16(ksrc+(long)(t)*KVBLK*DM,(unsigned)__builtin_amdgcn_readfirstlane(kdst+(slot)))
  #define DMA_V(t,slot) do{ glds16(vsrc+(long)(t)*KVBLK*DM,(unsigned)__builtin_amdgcn_readfirstlane(vdst+2*(slot))); glds16(vsrc+(long)(t)*KVBLK*DM+64,(unsigned)__builtin_amdgcn_readfirstlane(vdst+2*(slot)+8192)); }while(0)
  const int vb0=(int)(lds0+LDS_V)+((lane>>4)&1)*32+(lane&3)*8+(4*hi+((lane&15)>>2))*64;
  const char*Kbase=shm+LDS_K; bf16x8 kf[8];
  const lds_cptr shm3=(lds_cptr)shm; const lds_cptr kp0=shm3+LDS_K+hi*1024+r32*16; const lds_cptr vp0=shm3+LDS_V+((lane>>4)&1)*32+(lane&3)*8+(4*hi+((lane&15)>>2))*64;
  const int NT=(q0+QB)/KVBLK;
  DMA_K(0,0);DMA_V(0,0);DMA_K(1,SLOTB);
  bf16x8 qr[4];
  #pragma unroll
  for(int d0=0;d0<4;++d0)qr[d0]=*reinterpret_cast<const bf16x8*>(&Qw[(long)r32*DM+d0*16+hi*8]);
  float zz_; asm volatile("v_mov_b32 %0, 0":"=v"(zz_)); float mhat=0.f,l_reg=0.f;f32x16 o[4],negm;
  _Pragma("unroll") for(int r=0;r<16;++r){o[0][r]=zz_;o[1][r]=zz_;o[2][r]=zz_;o[3][r]=zz_;negm[r]=zz_;} asm volatile("":"+v"(negm));
  const int qrel=wid*QBLK+r32;
  #define CMASK(P0,P1,t) do{int jb_=(t)-(NT-4); if(jb_>=0){int hi_=hi,qr_=qrel; asm volatile("":"+v"(hi_),"+v"(qr_)); cmask(P0,P1,jb_,qr_,hi_);} }while(0)
  bool resc=false;
  #define START(P0,P1) do{ const float rm=rowmax(P0,P1); resc=false; \
    { const float dl=rm; mhat=fadd_s(mhat,dl); \
      _Pragma("unroll") for(int r=0;r<16;++r){P0[r]=fsub_s(P0[r],dl);P1[r]=fsub_s(P1[r],dl);} \
      _Pragma("unroll") for(int r=0;r<16;++r)negm[r]=-mhat; asm volatile("":"+v"(negm)); } \
    _Pragma("unroll") for(int r=0;r<16;++r)P0[r]=__builtin_amdgcn_exp2f(P0[r]); }while(0)
  #define RESC() do{ if(resc){ asm volatile("s_waitcnt lgkmcnt(0)":::"memory"); \
      _Pragma("unroll") for(int d_=0;d_<4;++d_) _Pragma("unroll") for(int r=0;r<16;++r)o[d_][r]*=wsf[crow(r,hi)]; } }while(0)
  f32x16 pA0,pA1,pB0,pB1;
  int sl_prev=0,sl_cur=0,sl_next=SLOTB;
  #define ROT() do{sl_prev=sl_cur;sl_cur=sl_next;sl_next=(sl_next==(NSLOT-1)*SLOTB)?0:sl_next+SLOTB;}while(0)
  DMA_K(2,2*SLOTB);
  WAIT_BAR(3);
  qkt(pA0,pA1,Kbase,qr,negm,r32,hi);asm volatile("s_nop 15\n\ts_nop 7":"+v"(pA0),"+v"(pA1));CMASK(pA0,pA1,0);
  START(pA0,pA1);
  _Pragma("unroll") for(int r=0;r<16;++r)pA1[r]=__builtin_amdgcn_exp2f(pA1[r]);
  WAIT_BAR(0);
  DMA_K(3,0);DMA_V(1,SLOTB);
  ROT();
  kload8(kf,kp0+sl_cur);
  WAIT_BAR(3);
  s16x4 vl[4],vh[4]; u32x4 pw0,pw1,pw2,pw3;
  #define PKW(P,B) cvtpk_s(P[B],P[B+1])
  #define PAF(k) __builtin_bit_cast(bf16x8,pw##k)
  #define VFS(g) (bf16x8){vl[(g)&3][0],vl[(g)&3][1],vl[(g)&3][2],vl[(g)&3][3],vh[(g)&3][0],vh[(g)&3][1],vh[(g)&3][2],vh[(g)&3][3]}
  #define PIN(x) asm volatile("":"+v"(x))
  #define MX3(a,b,c) __builtin_fmaxf(__builtin_fmaxf((a),(b)),(c))
  #define GAPA(MF,A0,A1,A2,A3,W0,W1,PW) do{ MF; sacc+=A0; sacc+=A1; sacc+=A2; sacc+=A3; PIN(sacc); W0; W1; PIN(PW); SBAR(); }while(0)
  #define EX(v) __builtin_amdgcn_exp2f(v)
  #define GAPB(MF,X,B) do{ MF; X[B]=EX(X[B]); X[B+1]=EX(X[B+1]); PIN(X); SBAR(); }while(0)
  #define VRD(g) do{ vl[(g)&3]=vtr(vp_+(((g)&3)*4096+((g)>>2)*1024)); vh[(g)&3]=vtr(vp_+(((g)&3)*4096+((g)>>2)*1024+512)); SBAR(); }while(0)
  #define KRD(G,j) do{ if(G){ kload2(kf,kp0+sl_next,j); SBAR(); } }while(0)
  #define STEP(C0,C1,P0,P1,t,GK,GV,GL) do{ SBAR(); \
    const lds_cptr vp_=vp0+2*sl_prev; \
    if(GV){DMA_V((t)+1,sl_next);} if(GK){DMA_K((t)+3,sl_cur);}   \
    float sacc=(P0[0]+P0[1]); __builtin_amdgcn_s_setprio(1); \
    GAPA(C0=__builtin_amdgcn_mfma_f32_32x32x16_bf16(kf[0],qr[0],negm,0,0,0), P0[2],P0[3],P0[4],P0[5],     pw0[0]=PKW(P0,0), pw0[1]=PKW(P0,2), pw0); \
    GAPA(C1=__builtin_amdgcn_mfma_f32_32x32x16_bf16(kf[1],qr[0],negm,0,0,0), P0[6],P0[7],P0[8],P0[9],     pw0[2]=PKW(P0,4), pw0[3]=PKW(P0,6), pw0); \
    GAPA(C0=__builtin_amdgcn_mfma_f32_32x32x16_bf16(kf[2],qr[1],C0,0,0,0),   P0[10],P0[11],P0[12],P0[13], pw1[0]=PKW(P0,8), pw1[1]=PKW(P0,10), pw1); \
    GAPA(C1=__builtin_amdgcn_mfma_f32_32x32x16_bf16(kf[3],qr[1],C1,0,0,0),   P0[14],P0[15],P1[0],P1[1],   pw1[2]=PKW(P0,12),pw1[3]=PKW(P0,14), pw1); \
    GAPA(C0=__builtin_amdgcn_mfma_f32_32x32x16_bf16(kf[4],qr[2],C0,0,0,0),   P1[2],P1[3],P1[4],P1[5],     pw2[0]=PKW(P1,0), pw2[1]=PKW(P1,2), pw2); \
    GAPA(C1=__builtin_amdgcn_mfma_f32_32x32x16_bf16(kf[5],qr[2],C1,0,0,0),   P1[6],P1[7],P1[8],P1[9],     pw2[2]=PKW(P1,4), pw2[3]=PKW(P1,6), pw2); \
    GAPA(C0=__builtin_amdgcn_mfma_f32_32x32x16_bf16(kf[6],qr[3],C0,0,0,0),   P1[10],P1[11],P1[12],P1[13], pw3[0]=PKW(P1,8), pw3[1]=PKW(P1,10), pw3); \
    GAPA(C1=__builtin_amdgcn_mfma_f32_32x32x16_bf16(kf[7],qr[3],C1,0,0,0),   P1[14],P1[15],0.f,0.f,       pw3[2]=PKW(P1,12),pw3[3]=PKW(P1,14), pw3); \
    __builtin_amdgcn_s_setprio(0); l_reg+=sacc; \
    VRD(0); VRD(1); VRD(2); \
    CMASK(C0,C1,t); \
    { float a=MX3(C0[0],C0[1],C1[0]),b=MX3(C0[2],C0[3],C1[1]); a=MX3(a,C1[2],C1[3]); \
      _Pragma("unroll") for(int r=4;r<16;r+=4){a=MX3(a,C0[r],C0[r+1]);b=MX3(b,C0[r+2],C0[r+3]);a=MX3(a,C1[r],C1[r+1]);b=MX3(b,C1[r+2],C1[r+3]);} \
      float rm=__builtin_fmaxf(a,b); { auto rr=__builtin_amdgcn_permlane32_swap(__float_as_uint(rm),__float_as_uint(rm),false,false); rm=__builtin_fmaxf(__uint_as_float(rr[0]),__uint_as_float(rr[1])); } \
      resc=false; \
      if(__builtin_expect(__any(rm>(float)THRL),0)){ const float dl=__builtin_fmaxf(rm,0.f); mhat+=dl; \
        _Pragma("unroll") for(int r=0;r<16;++r){C0[r]-=dl;C1[r]-=dl;} \
        _Pragma("unroll") for(int r=0;r<16;++r)negm[r]=-mhat; asm volatile("":"+v"(negm)); \
        const float f=__builtin_amdgcn_exp2f(-dl); l_reg*=f; if(hi==0)wsf[r32]=f; resc=true; } } \
    SBAR(); __builtin_amdgcn_s_setprio(1); \
    VRD(3);  GAPB(o[0]=__builtin_amdgcn_mfma_f32_32x32x16_bf16(PAF(0),VFS(0),o[0],0,0,0), C0,0); \
    VRD(4);  GAPB(o[1]=__builtin_amdgcn_mfma_f32_32x32x16_bf16(PAF(0),VFS(1),o[1],0,0,0), C0,2); \
    VRD(5);  GAPB(o[2]=__builtin_amdgcn_mfma_f32_32x32x16_bf16(PAF(0),VFS(2),o[2],0,0,0), C0,4); \
    VRD(6);  GAPB(o[3]=__builtin_amdgcn_mfma_f32_32x32x16_bf16(PAF(0),VFS(3),o[3],0,0,0), C0,6); \
    KRD(GL,0); VRD(7);  GAPB(o[0]=__builtin_amdgcn_mfma_f32_32x32x16_bf16(PAF(1),VFS(4),o[0],0,0,0), C0,8); \
    VRD(8);  GAPB(o[1]=__builtin_amdgcn_mfma_f32_32x32x16_bf16(PAF(1),VFS(5),o[1],0,0,0), C0,10); \
    KRD(GL,1); VRD(9);  GAPB(o[2]=__builtin_amdgcn_mfma_f32_32x32x16_bf16(PAF(1),VFS(6),o[2],0,0,0), C0,12); \
    VRD(10);  GAPB(o[3]=__builtin_amdgcn_mfma_f32_32x32x16_bf16(PAF(1),VFS(7),o[3],0,0,0), C0,14); \
    KRD(GL,2); VRD(11); GAPB(o[0]=__builtin_amdgcn_mfma_f32_32x32x16_bf16(PAF(2),VFS(8),o[0],0,0,0), C1,0); \
    VRD(12); GAPB(o[1]=__builtin_amdgcn_mfma_f32_32x32x16_bf16(PAF(2),VFS(9),o[1],0,0,0), C1,2); \
    KRD(GL,3); VRD(13); GAPB(o[2]=__builtin_amdgcn_mfma_f32_32x32x16_bf16(PAF(2),VFS(10),o[2],0,0,0), C1,4); \
    VRD(14); GAPB(o[3]=__builtin_amdgcn_mfma_f32_32x32x16_bf16(PAF(2),VFS(11),o[3],0,0,0), C1,6); \
    VRD(15); GAPB(o[0]=__builtin_amdgcn_mfma_f32_32x32x16_bf16(PAF(3),VFS(12),o[0],0,0,0), C1,8); \
    GAPB(o[1]=__builtin_amdgcn_mfma_f32_32x32x16_bf16(PAF(3),VFS(13),o[1],0,0,0), C1,10); \
    GAPB(o[2]=__builtin_amdgcn_mfma_f32_32x32x16_bf16(PAF(3),VFS(14),o[2],0,0,0), C1,12); \
    GAPB(o[3]=__builtin_amdgcn_mfma_f32_32x32x16_bf16(PAF(3),VFS(15),o[3],0,0,0), C1,14); __builtin_amdgcn_s_setprio(0); \
    }while(0)
  int t=1;
  #undef CMASK
  #define CMASK(P0,P1,t) do{}while(0)
  for(;t+5<NT;t+=2){
    STEP(pB0,pB1,pA0,pA1,t,true,true,true);     WAIT_BAR(3); RESC(); ROT();
    STEP(pA0,pA1,pB0,pB1,t+1,true,true,true);   WAIT_BAR(3); RESC(); ROT();
  }
  #undef CMASK
  #define CMASK(P0,P1,t) do{int jb_=(t)-(NT-4); if(jb_>=0){int hi_=hi,qr_=qrel; asm volatile("":"+v"(hi_),"+v"(qr_)); cmask(P0,P1,jb_,qr_,hi_);} }while(0)
  #define ENDW(tt) do{ if((tt)+3<NT){WAIT_BAR(3);} else if((tt)+2<NT){WAIT_BAR(2);} else {WAIT_BAR(0);} }while(0)
  for(;t+1<NT;t+=2){
    STEP(pB0,pB1,pA0,pA1,t,(t+3<NT),(t+1<NT),(t+1<NT));       ENDW(t);   RESC(); ROT();
    STEP(pA0,pA1,pB0,pB1,t+1,(t+4<NT),(t+2<NT),(t+2<NT));     ENDW(t+1); RESC(); ROT();
  }
  STEP(pB0,pB1,pA0,pA1,NT-1,false,false,false); RESC();
  { float sacc=pB0[0]+pB0[1]; _Pragma("unroll") for(int r=2;r<16;++r)sacc+=pB0[r]; _Pragma("unroll") for(int r=0;r<16;++r)sacc+=pB1[r]; l_reg+=sacc;
    pw0=(u32x4){PKW(pB0,0),PKW(pB0,2),PKW(pB0,4),PKW(pB0,6)};pw1=(u32x4){PKW(pB0,8),PKW(pB0,10),PKW(pB0,12),PKW(pB0,14)};pw2=(u32x4){PKW(pB1,0),PKW(pB1,2),PKW(pB1,4),PKW(pB1,6)};pw3=(u32x4){PKW(pB1,8),PKW(pB1,10),PKW(pB1,12),PKW(pB1,14)};
    SBAR(); pv(o,vb0+2*sl_cur,PAF(0),PAF(1),PAF(2),PAF(3)); }
  #undef PKW
  #undef PAF
  #undef VFS
  #undef PIN
  #undef MX3
  #undef GAPA
  #undef GAPB
  #undef EX
  #undef VRD
  #undef KRD
  #undef STEP
  #undef ENDW
  int lane_e; asm volatile("v_mbcnt_lo_u32_b32 %0, -1, 0\n\tv_mbcnt_hi_u32_b32 %0, -1, %0":"=v"(lane_e)); const int r32e=lane_e&31,hie=lane_e>>5;
  {auto rr=__builtin_amdgcn_permlane32_swap(__float_as_uint(l_reg),__float_as_uint(l_reg),false,false);l_reg=__uint_as_float(rr[0])+__uint_as_float(rr[1]);}
  float*wsfe=(float*)(shm+LDS_WS)+wid*64;
  if(hie==0)wsfe[32+r32e]=l_reg;asm volatile("s_waitcnt lgkmcnt(0)":::"memory");
  float rli[16];
  #pragma unroll
  for(int r=0;r<16;++r)rli[r]=__builtin_amdgcn_rcpf(wsfe[32+crow(r,hie)]);
  { bf16*stg=(bf16*)(shm+LDS_OST)+wid*4096;
    if(mode==0){
      #pragma unroll
      for(int r=0;r<16;++r){const int orow=crow(r,hie);
        #pragma unroll
        for(int d0=0;d0<4;++d0)stg[orow*128+d0*32+r32e]=__float2bfloat16(o[d0][r]*rli[r]);}
    } else {
      #pragma unroll
      for(int r=0;r<16;++r){const int orow=crow(r,hie);
        #pragma unroll
        for(int d0=0;d0<4;++d0){ bf16*p_=stg+orow*128+d0*32+r32e; const float c_=__bfloat162float(*p_)-lam*(o[d0][r]*rli[r]); *p_=__float2bfloat16(c_); } }
      asm volatile("s_waitcnt lgkmcnt(0)":::"memory");
      const int row=lane_e>>1,hf=lane_e&1; const long tok=(long)b*SEQ+qb*QB+wid*QBLK+row;
      u32x4 cv[8]; float ss=0.f;
      #pragma unroll
      for(int i=0;i<8;++i){ cv[i]=*(const u32x4*)(stg+row*128+hf*64+i*8);
        #pragma unroll
        for(int e=0;e<4;++e){ const float lo_=__uint_as_float(cv[i][e]<<16),hi_=__uint_as_float(cv[i][e]&0xffff0000u); ss+=lo_*lo_+hi_*hi_; } }
      ss+=__uint_as_float(__builtin_amdgcn_ds_bpermute((lane_e^1)<<2,__float_as_uint(ss)));
      const float rs=oml*__builtin_amdgcn_rsqf(ss*(1.0f/128.0f)+1e-6f);
      const bf16*bgp=BG+tok*DM+hf*64; bf16*op=O2p+tok*4096+hf*64; const float*gp=dng+hf*64;
      #pragma unroll
      for(int i=0;i<8;++i){ const u32x4 g_=*(const u32x4*)(bgp+i*8); u32x4 w_;
        #pragma unroll
        for(int e=0;e<4;++e){ const float c0=__uint_as_float(cv[i][e]<<16),c1=__uint_as_float(cv[i][e]&0xffff0000u);
          const float b0=__uint_as_float(g_[e]<<16),b1=__uint_as_float(g_[e]&0xffff0000u);
          const float s0=b0*__builtin_amdgcn_rcpf(1.0f+__builtin_amdgcn_exp2f(-1.4426950408889634f*b0)),s1=b1*__builtin_amdgcn_rcpf(1.0f+__builtin_amdgcn_exp2f(-1.4426950408889634f*b1));
          w_[e]=cvtpk_s(c0*rs*gp[i*8+2*e]*s0,c1*rs*gp[i*8+2*e+1]*s1); }
        *(u32x4*)(op+i*8)=w_; }
    } }
  asm volatile("s_waitcnt lgkmcnt(0)\n\ts_barrier":::"memory");
  #undef DMA_K
  #undef DMA_V
  #undef CMASK
  #undef START
  #undef RESC
  #undef ROT
}
constexpr int ATTN_LDS_BYTES=LDS_BYTES;
#undef SBAR
#undef WAIT_BAR
}
namespace cg = cooperative_groups;
#define LAS __attribute__((address_space(3)))
typedef unsigned short bf16;
typedef unsigned v4u __attribute__((ext_vector_type(4)));
typedef unsigned v2u __attribute__((ext_vector_type(2)));
typedef float f32x4 __attribute__((ext_vector_type(4)));
typedef short bf16x8 __attribute__((ext_vector_type(8)));

constexpr int NWAVES = 8, NTHR = 512;
constexpr int TOK = 8192, SEQL = 4096, DMOD = 2048, NIN = 18448, NPP = 18432, DEPTH = 4;
constexpr int C_AQ = 0, C_AK = 1024, C_AV = 2048, C_AG = 4096, C_BQ = 6144, C_BK = 8192, C_BV = 10240, C_BG = 12288, C_MA = 14336, C_MB = 16384;
constexpr float EPSN = 1e-6f;
constexpr size_t MiB = 1u << 20;
constexpr size_t WS_WLR = 1 * MiB;
constexpr size_t WS_WIN = 2 * MiB;
constexpr size_t WS_WABO = 290 * MiB;
constexpr size_t WS_H = 386 * MiB;
constexpr size_t WS_P = 418 * MiB;
constexpr size_t WS_ALR = 706 * MiB;
constexpr size_t WS_QG = 707 * MiB;
constexpr size_t WS_KHT = 723 * MiB;
constexpr size_t WS_VTG = 739 * MiB;
constexpr size_t WS_DG = 771 * MiB;
constexpr size_t WS_OG = 772 * MiB;
constexpr size_t WS_OB = 836 * MiB;
constexpr size_t WS_OA = 900 * MiB;
constexpr size_t WS_OBF = 932 * MiB;
constexpr size_t WS_T1 = 964 * MiB;
constexpr size_t WS_MG = 1028 * MiB;
constexpr size_t WS_OUT = 1060 * MiB;
constexpr size_t WS_PS = 1124 * MiB;
constexpr size_t WS_END = 1125 * MiB;
constexpr int LDS_BYTES = 147456;
constexpr int MISC_OFF = 147456 - 256;
constexpr int CW_BAR = 4096;
constexpr size_t CTL_ZERO_BYTES = 1 * MiB;
constexpr int CW_XCNT = 16384;
constexpr int CW_QUEUE = 8192;

#define LDS_WAIT() asm volatile("s_waitcnt lgkmcnt(0)" ::: "memory")
__device__ __forceinline__ unsigned f2bf(float f) { unsigned u = __builtin_bit_cast(unsigned, f); return (u + 0x7fffu + ((u >> 16) & 1u)) >> 16; }
typedef float f32x2_t_ __attribute__((ext_vector_type(2))); typedef __bf16 bf16x2_t_ __attribute__((ext_vector_type(2)));
__device__ __forceinline__ unsigned pk2(float lo, float hi) { f32x2_t_ v = {lo, hi}; bf16x2_t_ b = __builtin_convertvector(v, bf16x2_t_); return __builtin_bit_cast(unsigned, b); }
__device__ __forceinline__ float bf2f(unsigned short b) { return __uint_as_float(((unsigned)b) << 16); }
__device__ __forceinline__ float blo(unsigned w) { return __uint_as_float(w << 16); }
__device__ __forceinline__ float bhi(unsigned w) { return __uint_as_float(w & 0xffff0000u); }
__device__ __forceinline__ float shx(float v, int m, int lane) { return __uint_as_float(__builtin_amdgcn_ds_bpermute(((lane ^ m) & 63) << 2, __float_as_uint(v))); }
__device__ __forceinline__ float wave_sum(float v, int lane) {
#pragma unroll
    for (int o = 1; o < 64; o <<= 1) v += shx(v, o, lane);
    return v;
}
__device__ __forceinline__ float fexp(float x) { return __builtin_amdgcn_exp2f(1.4426950408889634f * x); }
__device__ __forceinline__ float siluf(float x) { return x * __builtin_amdgcn_rcpf(1.0f + fexp(-x)); }

#define XB_TMO      128
#define XB_XCNT(j)  (256  + 64 * (j))
#define XB_XSUB(j)  (1280 + 64 * (j))
#define XB_XGEN(j)  (2304 + 64 * (j))
#define XB_TOP      3328
#define XB_TOPGEN   3392
#define XCD_BAR_WORDS 3456
#define XB_SPIN_CAP (1u << 18)

__device__ __forceinline__ unsigned xb_ld(unsigned* p)              { return __hip_atomic_load(p, __ATOMIC_RELAXED, __HIP_MEMORY_SCOPE_AGENT); }
__device__ __forceinline__ unsigned xb_add(unsigned* p, unsigned v) { return __hip_atomic_fetch_add(p, v, __ATOMIC_RELAXED, __HIP_MEMORY_SCOPE_AGENT); }
__device__ __forceinline__ unsigned xb_xcc_id() { return (unsigned)__builtin_amdgcn_s_getreg((3 << 11) | 20) & 0xFu; }
#define XB_SPIN(cond, bar) do { unsigned _sp = 0; while (cond) { __builtin_amdgcn_s_sleep(1); \
    if ((++_sp & 255u) == 0u) { if (xb_ld(&(bar)[XB_TMO])) break; if (_sp > XB_SPIN_CAP) { atomicAdd(&(bar)[XB_TMO], 1u); break; } } } } while (0)

struct XcdBarrier {
    unsigned* bar; unsigned x;
    volatile LAS unsigned* st;
};

__device__ __forceinline__ XcdBarrier xcd_barrier_post(unsigned* bar, volatile LAS unsigned* st, int tid) {
    XcdBarrier b; b.bar = bar; b.x = xb_xcc_id(); b.st = st;
    if (tid == 0) (void)xb_add(&bar[XB_XCNT(b.x)], 1u);
    return b;
}
__device__ __forceinline__ void xcd_barrier_complete(unsigned* bar, unsigned x, unsigned& nloc, unsigned& nx) {
    const unsigned G = gridDim.x * gridDim.y * gridDim.z;
    unsigned sum, cnt, mine, sp = 0u;
    for (;;) {
        sum = 0u; cnt = 0u; mine = 0u;
#pragma unroll
        for (unsigned j = 0; j < 16; ++j) { const unsigned c = xb_ld(&bar[XB_XCNT(j)]); sum += c; cnt += (c > 0u) ? 1u : 0u; mine = (j == x) ? c : mine; }
        if (sum == G) break;
        __builtin_amdgcn_s_sleep(1);
        if ((++sp & 255u) == 0u) { if (xb_ld(&bar[XB_TMO])) break; if (sp > XB_SPIN_CAP) { atomicAdd(&bar[XB_TMO], 1u); break; } }
    }
    nloc = mine > 0u ? mine : 1u; nx = cnt > 0u ? cnt : 1u;
}

__device__ __forceinline__ void xcd_barrier(const XcdBarrier& b, int tid) {
    asm volatile("s_waitcnt vmcnt(0)" ::: "memory");
    __syncthreads();
    if (tid == 0) {
        unsigned* bar = b.bar;
        __builtin_amdgcn_s_waitcnt(0);
        unsigned nloc = b.st[0], nx = b.st[1];
        if (nloc == 0u) { xcd_barrier_complete(bar, b.x, nloc, nx); b.st[0] = nloc; b.st[1] = nx; }
        const unsigned old = xb_add(&bar[XB_XSUB(b.x)], 1u);
        const unsigned gen = old / nloc;
        if (old + 1u == (gen + 1u) * nloc) {
            __builtin_amdgcn_fence(__ATOMIC_RELEASE, "agent");
            asm volatile("s_waitcnt vmcnt(0)" ::: "memory");
            const unsigned og = xb_add(&bar[XB_TOP], 1u);
            const unsigned tg = og / nx;
            if (og + 1u == (tg + 1u) * nx) xb_add(&bar[XB_TOPGEN], 1u);
            else XB_SPIN(xb_ld(&bar[XB_TOPGEN]) == tg, bar);
            __builtin_amdgcn_fence(__ATOMIC_ACQUIRE, "agent");
            xb_add(&bar[XB_XGEN(b.x)], 1u);
            asm volatile("s_waitcnt vmcnt(0)" ::: "memory");
        } else {
            XB_SPIN(xb_ld(&bar[XB_XGEN(b.x)]) == gen, bar);
            __builtin_amdgcn_fence(__ATOMIC_ACQUIRE, "agent");
            asm volatile("s_waitcnt vmcnt(0)" ::: "memory");
        }
    }
    __syncthreads();
}

__device__ __forceinline__ void transpose_item(const float* W, int ldw, int K, int N, bf16* WT, LAS float* scr, int item, int lane) {
    const int nblk = N / 32, kb = item / nblk, nb = item % nblk, k0 = 64 * kb, n0 = 32 * nb;
    const int kr = lane >> 3, c4 = lane & 7;
    f32x4 r[8];
#pragma unroll
    for (int i = 0; i < 8; ++i) r[i] = *(const f32x4*)(W + (size_t)(k0 + 8 * i + kr) * ldw + n0 + 4 * c4);
#pragma unroll
    for (int i = 0; i < 8; ++i) { LAS float* d = scr + (8 * i + kr) * 33 + 4 * c4; d[0] = r[i].x; d[1] = r[i].y; d[2] = r[i].z; d[3] = r[i].w; }
    LDS_WAIT(); asm volatile("" ::: "memory");
    const int c = lane & 7;
#pragma unroll
    for (int j = 0; j < 4; ++j) { const int n = (lane >> 3) + 8 * j; const LAS float* s = scr + (8 * c) * 33 + n;
        v4u o; o.x = pk2(s[0 * 33], s[1 * 33]); o.y = pk2(s[2 * 33], s[3 * 33]); o.z = pk2(s[4 * 33], s[5 * 33]); o.w = pk2(s[6 * 33], s[7 * 33]);
        *(v4u*)(WT + (size_t)(n0 + n) * K + k0 + 8 * c) = o; }
    LDS_WAIT(); asm volatile("" ::: "memory");
}

struct Args { const float* in[12]; float* out; unsigned char* ws; int ph_lo, ph_hi; };
typedef const Args __attribute__((address_space(4))) CArgs;

constexpr int CV_I1 = 32 * (6144 / 32), CV_I2 = 32 * (12288 / 32), CV_I3 = 32 * (2048 / 32), CV_PER = CV_I1 + CV_I2 + 3 * CV_I3;
constexpr int CV_UNITS = CV_PER / 256;
__device__ __forceinline__ void convert_item(CArgs& a, int l, int r, LAS float* scr, int lane) {
    const float* win = a.in[3] + (size_t)l * DMOD * NIN;
    bf16* wt = (bf16*)(a.ws + WS_WIN) + (size_t)l * NPP * DMOD;
    bf16* wabo = (bf16*)(a.ws + WS_WABO) + (size_t)l * 3 * DMOD * DMOD;
    if (r < CV_I1) { transpose_item(win, NIN, DMOD, 6144, wt, scr, r, lane); return; } r -= CV_I1;
    if (r < CV_I2) { transpose_item(win + 6160, NIN, DMOD, 12288, wt + (size_t)6144 * DMOD, scr, r, lane); return; } r -= CV_I2;
    if (r < CV_I3) { transpose_item(a.in[9] + (size_t)l * DMOD * DMOD, DMOD, 2 * DMOD, DMOD, wabo, scr, r, lane); return; } r -= CV_I3;
    if (r < CV_I3) { transpose_item(a.in[10] + (size_t)l * DMOD * DMOD, DMOD, 2 * DMOD, DMOD, wabo + DMOD, scr, r, lane); return; } r -= CV_I3;
    transpose_item(a.in[11] + (size_t)l * DMOD * DMOD, DMOD, DMOD, DMOD, wabo + (size_t)2 * DMOD * DMOD, scr, r, lane);
}
struct CvItem { const float* W; bf16* WT; int ldw, K, k0, n0; };
__device__ __forceinline__ CvItem cv_decode(CArgs& a, int l, int r) {
    const float* win = a.in[3] + (size_t)l * DMOD * NIN;
    bf16* wt = (bf16*)(a.ws + WS_WIN) + (size_t)l * NPP * DMOD;
    bf16* wabo = (bf16*)(a.ws + WS_WABO) + (size_t)l * 3 * DMOD * DMOD;
    CvItem c; int N;
    if (r < CV_I1) { c.W = win; c.ldw = NIN; c.K = DMOD; N = 6144; c.WT = wt; }
    else if ((r -= CV_I1) < CV_I2) { c.W = win + 6160; c.ldw = NIN; c.K = DMOD; N = 12288; c.WT = wt + (size_t)6144 * DMOD; }
    else if ((r -= CV_I2) < CV_I3) { c.W = a.in[9] + (size_t)l * DMOD * DMOD; c.ldw = DMOD; c.K = 2 * DMOD; N = DMOD; c.WT = wabo; }
    else if ((r -= CV_I3) < CV_I3) { c.W = a.in[10] + (size_t)l * DMOD * DMOD; c.ldw = DMOD; c.K = 2 * DMOD; N = DMOD; c.WT = wabo + DMOD; }
    else { r -= CV_I3; c.W = a.in[11] + (size_t)l * DMOD * DMOD; c.ldw = DMOD; c.K = DMOD; N = DMOD; c.WT = wabo + (size_t)2 * DMOD * DMOD; }
    const int nblk = N / 32; c.k0 = 64 * (r / nblk); c.n0 = 32 * (r % nblk);
    return c;
}
__device__ __forceinline__ void cv_load(const CvItem& c, f32x4 (&r)[8], int lane) {
    const int kr = lane >> 3, c4 = lane & 7;
#pragma unroll
    for (int i = 0; i < 8; ++i) r[i] = *(const f32x4*)(c.W + (size_t)(c.k0 + 8 * i + kr) * c.ldw + c.n0 + 4 * c4);
}
__device__ __forceinline__ void cv_store(const CvItem& c, const f32x4 (&r)[8], LAS float* scr, int lane) {
    const int kr = lane >> 3, c4 = lane & 7;
#pragma unroll
    for (int i = 0; i < 8; ++i) { LAS float* d = scr + (8 * i + kr) * 33 + 4 * c4; d[0] = r[i].x; d[1] = r[i].y; d[2] = r[i].z; d[3] = r[i].w; }
    LDS_WAIT(); asm volatile("" ::: "memory");
    const int cc = lane & 7;
#pragma unroll
    for (int j = 0; j < 4; ++j) { const int n = (lane >> 3) + 8 * j; const LAS float* s = scr + (8 * cc) * 33 + n;
        v4u o; o.x = pk2(s[0 * 33], s[1 * 33]); o.y = pk2(s[2 * 33], s[3 * 33]); o.z = pk2(s[4 * 33], s[5 * 33]); o.w = pk2(s[6 * 33], s[7 * 33]);
        *(v4u*)(c.WT + (size_t)(c.n0 + n) * c.K + c.k0 + 8 * cc) = o; }
    LDS_WAIT(); asm volatile("" ::: "memory");
}
__device__ __forceinline__ void convert_wlr_item(CArgs& a, int l, int it, int lane) {
    const int k = it * 64 + lane;
    const f32x4* wp = (const f32x4*)(a.in[3] + (size_t)l * DMOD * NIN + (size_t)k * NIN + 6144);
    bf16* o = (bf16*)(a.ws + WS_WLR) + (size_t)l * 16 * DMOD + k;
#pragma unroll
    for (int c = 0; c < 4; ++c) { const f32x4 w = wp[c];
        o[(size_t)(4 * c + 0) * DMOD] = (bf16)f2bf(w.x); o[(size_t)(4 * c + 1) * DMOD] = (bf16)f2bf(w.y); o[(size_t)(4 * c + 2) * DMOD] = (bf16)f2bf(w.z); o[(size_t)(4 * c + 3) * DMOD] = (bf16)f2bf(w.w); }
}
__device__ __forceinline__ void convert_unit(CArgs& a, LAS unsigned char* lds, int l, int c, int wave, int lane) {
    LAS float* scr = (LAS float*)(lds + wave * 16384);
    if (c == 0) for (int i = 0; i < 4; ++i) convert_wlr_item(a, l, wave + 8 * i, lane);
    f32x4 ra[8], rb[8];
    CvItem ca = cv_decode(a, l, c * 256 + wave), cb;
    cv_load(ca, ra, lane);
#pragma unroll 1
    for (int i = 0; i < 32; i += 2) {
        cb = cv_decode(a, l, c * 256 + wave + 8 * (i + 1)); cv_load(cb, rb, lane);
        cv_store(ca, ra, scr, lane);
        if (i + 2 < 32) { ca = cv_decode(a, l, c * 256 + wave + 8 * (i + 2)); cv_load(ca, ra, lane); }
        cv_store(cb, rb, scr, lane);
    }
}
__device__ __forceinline__ void phase_weights(CArgs& a, LAS unsigned char* lds, int gw, int NGW, int wave, int lane) {
    LAS float* scr = (LAS float*)(lds + wave * 16384);
    if (gw < 32) convert_wlr_item(a, 0, gw, lane);
    for (int it = gw; it < CV_PER; it += NGW) convert_item(a, 0, it, scr, lane);
}

__device__ __forceinline__ void phase_norm(CArgs& a, LAS unsigned char* lds, int l, int gw, int NGW, int wave, int lane) {
    const float* xprev = (l <= 1) ? a.in[0] : a.out;
    const bf16* OUT = (const bf16*)(a.ws + WS_OUT); const float* PS = (const float*)(a.ws + WS_PS);
    bf16* H = (bf16*)(a.ws + WS_H); float* ALR = (float*)(a.ws + WS_ALR);
    LAS unsigned char* hrow = lds + wave * 16384;
    const int fr = lane & 15, fq = lane >> 4;
    for (int row0 = gw; row0 < TOK; row0 += 4 * NGW) {
#pragma unroll 1
        for (int rp = 0; rp < 2; ++rp) {
            f32x4 v[2][8]; v2u ov[2][8]; float ps[2];
#pragma unroll
            for (int q = 0; q < 2; ++q) { const int row = row0 + (2 * rp + q) * NGW;
                const f32x4* xr = (const f32x4*)(xprev + (size_t)row * DMOD) + lane;
#pragma unroll
                for (int j = 0; j < 8; ++j) v[q][j] = xr[64 * j];
                if (l > 0) { const v2u* orow = (const v2u*)(OUT + (size_t)row * DMOD) + lane;
#pragma unroll
                    for (int j = 0; j < 8; ++j) ov[q][j] = orow[64 * j];
                    ps[q] = (lane < 32) ? PS[(size_t)row * 32 + lane] : 0.f; } }
#pragma unroll
            for (int q = 0; q < 2; ++q) { const int row = row0 + (2 * rp + q) * NGW; const int ri = 2 * rp + q;
                if (l > 0) {
                    const f32x4* gp = (const f32x4*)(a.in[2] + (size_t)(l - 1) * DMOD) + lane;
                    const float rs = 1.0f / sqrtf(wave_sum(ps[q], lane) * (1.0f / DMOD) + EPSN);
                    f32x4* xo = (f32x4*)(a.out + (size_t)row * DMOD) + lane;
#pragma unroll
                    for (int j = 0; j < 8; ++j) { const v2u ow_ = ov[q][j]; v[q][j] = v[q][j] + (f32x4){blo(ow_.x), bhi(ow_.x), blo(ow_.y), bhi(ow_.y)} * rs * gp[64 * j]; xo[64 * j] = v[q][j]; }
                }
                if (l == DEPTH) continue;
                float s = 0.f;
#pragma unroll
                for (int j = 0; j < 8; ++j) s += (v[q][j].x * v[q][j].x + v[q][j].y * v[q][j].y) + (v[q][j].z * v[q][j].z + v[q][j].w * v[q][j].w);
                const float rs2 = 1.0f / sqrtf(wave_sum(s, lane) * (1.0f / DMOD) + EPSN);
                const f32x4* gq = (const f32x4*)(a.in[1] + (size_t)l * DMOD) + lane;
                unsigned long long* o8 = (unsigned long long*)(H + (size_t)row * DMOD) + lane;
#pragma unroll
                for (int j = 0; j < 8; ++j) {
                    const f32x4 hv = v[q][j] * rs2 * gq[64 * j];
                    const unsigned long long w = (unsigned long long)pk2(hv.x, hv.y) | ((unsigned long long)pk2(hv.z, hv.w) << 32);
                    o8[64 * j] = w;
                    *(LAS unsigned long long*)(hrow + ri * 4096 + (256 * j + 4 * lane) * 2) = w;
                }
            }
        }
        if (l == DEPTH) continue;
        LDS_WAIT(); asm volatile("" ::: "memory");
        const bf16* wlr = (const bf16*)(a.ws + WS_WLR) + (size_t)l * 16 * DMOD + (size_t)fr * DMOD + 8 * fq;
        f32x4 acc = (f32x4){0.f, 0.f, 0.f, 0.f};
#pragma unroll 1
        for (int kb = 0; kb < 64; kb += 16) {
            bf16x8 Xb[16];
#pragma unroll
            for (int i = 0; i < 16; ++i) Xb[i] = *(const bf16x8*)(wlr + (kb + i) * 32);
#pragma unroll
            for (int i = 0; i < 16; ++i) {
                bf16x8 Y = (bf16x8){0, 0, 0, 0, 0, 0, 0, 0};
                if (fr < 4) Y = *(const LAS bf16x8*)(hrow + fr * 4096 + ((kb + i) * 32 + 8 * fq) * 2);
                acc = __builtin_amdgcn_mfma_f32_16x16x32_bf16(Xb[i], Y, acc, 0, 0, 0);
            }
        }
        if (fr < 4) { const int row = row0 + fr * NGW; if (row < TOK) *(f32x4*)(ALR + (size_t)row * 16 + 4 * fq) = acc; }
        LDS_WAIT(); asm volatile("" ::: "memory");
    }
}

__device__ __forceinline__ void alr_from_h(CArgs& a, LAS unsigned char* lds, int l, int gw, int NGW, int wave, int lane) {
    const bf16* H = (const bf16*)(a.ws + WS_H); float* ALR = (float*)(a.ws + WS_ALR);
    LAS unsigned char* hrow = lds + wave * 16384;
    const int fr = lane & 15, fq = lane >> 4;
    for (int row0 = gw; row0 < TOK; row0 += 4 * NGW) {
        v4u hr[4][4];
#pragma unroll
        for (int ri = 0; ri < 4; ++ri)
#pragma unroll
            for (int j = 0; j < 4; ++j) hr[ri][j] = *(const v4u*)(H + (size_t)(row0 + ri * NGW) * DMOD + (j * 64 + lane) * 8);
#pragma unroll
        for (int ri = 0; ri < 4; ++ri)
#pragma unroll
            for (int j = 0; j < 4; ++j) *(LAS v4u*)(hrow + ri * 4096 + (j * 64 + lane) * 16) = hr[ri][j];
        LDS_WAIT(); asm volatile("" ::: "memory");
        const bf16* wlr = (const bf16*)(a.ws + WS_WLR) + (size_t)l * 16 * DMOD + (size_t)fr * DMOD + 8 * fq;
        f32x4 acc = (f32x4){0.f, 0.f, 0.f, 0.f};
#pragma unroll 1
        for (int kb = 0; kb < 64; kb += 16) {
            bf16x8 Xb[16];
#pragma unroll
            for (int i = 0; i < 16; ++i) Xb[i] = *(const bf16x8*)(wlr + (kb + i) * 32);
#pragma unroll
            for (int i = 0; i < 16; ++i) {
                bf16x8 Y = (bf16x8){0, 0, 0, 0, 0, 0, 0, 0};
                if (fr < 4) Y = *(const LAS bf16x8*)(hrow + fr * 4096 + ((kb + i) * 32 + 8 * fq) * 2);
                acc = __builtin_amdgcn_mfma_f32_16x16x32_bf16(Xb[i], Y, acc, 0, 0, 0);
            }
        }
        if (fr < 4) *(f32x4*)(ALR + (size_t)(row0 + fr * NGW) * 16 + 4 * fq) = acc;
        LDS_WAIT(); asm volatile("" ::: "memory");
    }
}

constexpr int QPB = 528;
constexpr int TPB = 144;
__device__ __forceinline__ bf16x8 ldfrag(const LAS unsigned char* p) { return *(const LAS bf16x8*)p; }

__device__ __forceinline__ void load_v_half_regs(v4u (&r)[4], const bf16* P, int token0, int h, int vh, int tid) {
#pragma unroll
    for (int j = 0; j < 4; ++j) { const int c = tid + j * NTHR, chi = c >> 6, ln = c & 63; const int s = (chi & 3) * 16 + (ln & 15), ch = (chi >> 2) * 4 + (ln >> 4);
        r[j] = *(const v4u*)(P + (size_t)(token0 + s) * NPP + C_AV + h * 512 + vh * 256 + ch * 8); }
}
__device__ __forceinline__ void store_v_half(LAS unsigned char* VT, const v4u (&r)[4], int tid) {
#pragma unroll
    for (int j = 0; j < 4; ++j) { const int c = tid + j * NTHR, chi = c >> 6, ln = c & 63; const int s = (chi & 3) * 16 + (ln & 15), ch = (chi >> 2) * 4 + (ln >> 4);
        const v4u v = r[j];
        LAS unsigned short* d = (LAS unsigned short*)(VT + (ch * 8) * TPB + s * 2);
        d[0 * (TPB / 2)] = (unsigned short)(v.x & 0xffffu); d[1 * (TPB / 2)] = (unsigned short)(v.x >> 16);
        d[2 * (TPB / 2)] = (unsigned short)(v.y & 0xffffu); d[3 * (TPB / 2)] = (unsigned short)(v.y >> 16);
        d[4 * (TPB / 2)] = (unsigned short)(v.z & 0xffffu); d[5 * (TPB / 2)] = (unsigned short)(v.z >> 16);
        d[6 * (TPB / 2)] = (unsigned short)(v.w & 0xffffu); d[7 * (TPB / 2)] = (unsigned short)(v.w >> 16); }
}

__device__ __forceinline__ void gla_intra_unit(CArgs& a, int l, LAS unsigned char* lds, int b, int n, int h, const int tid) {
    const int lane = tid & 63, wid = __builtin_amdgcn_readfirstlane(tid >> 6), fr = lane & 15, fq = lane >> 4;
    LAS unsigned char* QT = lds; LAS unsigned char* KT = lds + 33792; LAS unsigned char* AS = lds + 67584; LAS unsigned char* VT = lds + 76800;
    LAS float* BB = (LAS float*)(lds + 76800);
    LAS float* BL = (LAS float*)(lds + 142336);
    LAS float* HT = (LAS float*)(lds + 143360);
    const int token0 = b * SEQL + n * 64; const int unit = (b * 64 + n) * 4 + h;
    const bf16* P = (const bf16*)(a.ws + WS_P);
    bf16* QG = (bf16*)(a.ws + WS_QG); bf16* KHT = (bf16*)(a.ws + WS_KHT) + (size_t)unit * 256 * 64; bf16* VTG = (bf16*)(a.ws + WS_VTG) + (size_t)unit * 512 * 64;
    float* DG = (float*)(a.ws + WS_DG) + (size_t)unit * 256; bf16* OG = (bf16*)(a.ws + WS_OG);
    const float* ALR = (const float*)(a.ws + WS_ALR);
    v4u rq[4], rk[4];
#pragma unroll
    for (int j = 0; j < 4; ++j) { const int idx = tid + j * NTHR; const bf16* p = P + (size_t)(token0 + (idx >> 5)) * NPP + h * 256 + (idx & 31) * 8; rq[j] = *(const v4u*)(p + C_AQ); rk[j] = *(const v4u*)(p + C_AK); }
    v4u rv0[4], rv1[4];
    load_v_half_regs(rv0, P, token0, h, 0, tid); load_v_half_regs(rv1, P, token0, h, 1, tid);
    const int k = tid & 255, th = wid >> 2;
    LAS float* ALS = (LAS float*)(lds + 67584);
    if (tid < 256) *(LAS f32x4*)(ALS + tid * 4) = *(const f32x4*)(ALR + (size_t)token0 * 16 + tid * 4);
    __syncthreads();
    {
        float w2c[16];
#pragma unroll
        for (int r = 0; r < 16; ++r) w2c[r] = a.in[4][((size_t)l * 16 + r) * 1024 + h * 256 + k];
        const float bias = a.in[5][(size_t)l * 1024 + h * 256 + k];
        float cs[32]; float bc = 0.f;
#pragma unroll
        for (int t = 0; t < 32; ++t) {
            const LAS f32x4* al = (const LAS f32x4*)(ALS + (th * 32 + t) * 16);
            const f32x4 a0 = al[0], a1 = al[1], a2 = al[2], a3 = al[3];
            float lg = bias;
            lg += a0.x * w2c[0]; lg += a0.y * w2c[1]; lg += a0.z * w2c[2]; lg += a0.w * w2c[3]; lg += a1.x * w2c[4]; lg += a1.y * w2c[5]; lg += a1.z * w2c[6]; lg += a1.w * w2c[7];
            lg += a2.x * w2c[8]; lg += a2.y * w2c[9]; lg += a2.z * w2c[10]; lg += a2.w * w2c[11]; lg += a3.x * w2c[12]; lg += a3.y * w2c[13]; lg += a3.z * w2c[14]; lg += a3.w * w2c[15];
            const float ls = fminf(lg, 0.f) - __logf(1.0f + fexp(-fabsf(lg)));
            bc += ls * 0.0625f; cs[t] = bc;
        }
        HT[th * 256 + k] = bc;
        __syncthreads();
        const float h0 = HT[k], h1 = HT[256 + k]; const float off = th ? h0 : 0.f;
#pragma unroll
        for (int t = 0; t < 32; ++t) BB[(th * 32 + t) * 256 + k] = cs[t] + off;
        if (th == 0) { BL[k] = h0 + h1; DG[k] = fexp(h0 + h1); }
    }
    __syncthreads();
#pragma unroll
    for (int j = 0; j < 4; ++j) {
        const int idx = tid + j * NTHR, t = idx >> 5, kc = (idx & 31) * 8;
        const f32x4 b0 = *(const LAS f32x4*)(BB + t * 256 + kc), b1 = *(const LAS f32x4*)(BB + t * 256 + kc + 4);
        const float e0 = fexp(b0.x), e1 = fexp(b0.y), e2 = fexp(b0.z), e3 = fexp(b0.w), e4 = fexp(b1.x), e5 = fexp(b1.y), e6 = fexp(b1.z), e7 = fexp(b1.w);
        const float i0 = fexp(-b0.x), i1 = fexp(-b0.y), i2 = fexp(-b0.z), i3 = fexp(-b0.w), i4 = fexp(-b1.x), i5 = fexp(-b1.y), i6 = fexp(-b1.z), i7 = fexp(-b1.w);
        const v4u q = rq[j], kk = rk[j]; v4u qo, ko;
        qo.x = pk2(blo(q.x) * e0, bhi(q.x) * e1); qo.y = pk2(blo(q.y) * e2, bhi(q.y) * e3); qo.z = pk2(blo(q.z) * e4, bhi(q.z) * e5); qo.w = pk2(blo(q.w) * e6, bhi(q.w) * e7);
        ko.x = pk2(blo(kk.x) * i0, bhi(kk.x) * i1); ko.y = pk2(blo(kk.y) * i2, bhi(kk.y) * i3); ko.z = pk2(blo(kk.z) * i4, bhi(kk.z) * i5); ko.w = pk2(blo(kk.w) * i6, bhi(kk.w) * i7);
        *(LAS v4u*)(QT + t * QPB + kc * 2) = qo; *(LAS v4u*)(KT + t * QPB + kc * 2) = ko;
        *(v4u*)(QG + (size_t)(token0 + t) * 1024 + h * 256 + kc) = qo;
    }
    __syncthreads();
    {
        const float el = fexp(BL[k]);
#pragma unroll
        for (int t8 = 0; t8 < 4; ++t8) {
            float kv[8];
#pragma unroll
            for (int i = 0; i < 8; ++i) kv[i] = bf2f(*(const LAS unsigned short*)(KT + (th * 32 + t8 * 8 + i) * QPB + k * 2)) * el;
            v4u o; o.x = pk2(kv[0], kv[1]); o.y = pk2(kv[2], kv[3]); o.z = pk2(kv[4], kv[5]); o.w = pk2(kv[6], kv[7]);
            *(v4u*)(KHT + (size_t)k * 64 + th * 32 + t8 * 8) = o;
        }
    }
#pragma unroll
    for (int tt = 0; tt < 2; ++tt) {
        const int tile = 2 * wid + tt, si = tile >> 2, ti = tile & 3;
        f32x4 acc = (f32x4){0.f, 0.f, 0.f, 0.f};
        if (si <= ti) {
#pragma unroll
            for (int kk = 0; kk < 8; ++kk) {
                const bf16x8 X = ldfrag(KT + (si * 16 + fr) * QPB + (kk * 32 + 8 * fq) * 2);
                const bf16x8 Y = ldfrag(QT + (ti * 16 + fr) * QPB + (kk * 32 + 8 * fq) * 2);
                acc = __builtin_amdgcn_mfma_f32_16x16x32_bf16(X, Y, acc, 0, 0, 0);
            }
        }
        const int s0 = si * 16 + 4 * fq, t = ti * 16 + fr;
#pragma unroll
        for (int r = 0; r < 4; ++r) if (s0 + r > t) acc[r] = 0.f;
        v2u w; w.x = pk2(acc[0], acc[1]); w.y = pk2(acc[2], acc[3]);
        *(LAS v2u*)(AS + t * TPB + s0 * 2) = w;
    }
#pragma unroll 1
    for (int vh = 0; vh < 2; ++vh) {
        if (vh == 0) store_v_half(VT, rv0, tid); else store_v_half(VT, rv1, tid);
        __syncthreads();
        bf16x8 Yf[4][2];
#pragma unroll
        for (int tt = 0; tt < 4; ++tt)
#pragma unroll
            for (int ks = 0; ks < 2; ++ks) Yf[tt][ks] = ldfrag(AS + (tt * 16 + fr) * TPB + (ks * 32 + 8 * fq) * 2);
#pragma unroll
        for (int v2 = 0; v2 < 2; ++v2) {
            const int vt = 2 * wid + v2;
            const bf16x8 X0 = ldfrag(VT + (vt * 16 + fr) * TPB + (8 * fq) * 2), X1 = ldfrag(VT + (vt * 16 + fr) * TPB + (32 + 8 * fq) * 2);
#pragma unroll
            for (int tt = 0; tt < 4; ++tt) {
                f32x4 acc = (f32x4){0.f, 0.f, 0.f, 0.f};
                acc = __builtin_amdgcn_mfma_f32_16x16x32_bf16(X0, Yf[tt][0], acc, 0, 0, 0);
                acc = __builtin_amdgcn_mfma_f32_16x16x32_bf16(X1, Yf[tt][1], acc, 0, 0, 0);
                { v2u w_; w_.x = pk2(acc[0], acc[1]); w_.y = pk2(acc[2], acc[3]); *(v2u*)(OG + (size_t)(token0 + tt * 16 + fr) * DMOD + h * 512 + vh * 256 + vt * 16 + 4 * fq) = w_; }
            }
        }
#pragma unroll
        for (int j = 0; j < 4; ++j) { const int idx = tid + j * NTHR, vrow = idx >> 3, c8 = idx & 7;
            *(v4u*)(VTG + (size_t)(vh * 256 + vrow) * 64 + c8 * 8) = *(const LAS v4u*)(VT + vrow * TPB + c8 * 16); }
        __syncthreads();
    }
}

__device__ __forceinline__ void gla_inter_unit(CArgs& a, LAS unsigned char* lds, int bh, int vs, const int tid) {
    const int lane = tid & 63, wid = __builtin_amdgcn_readfirstlane(tid >> 6), fr = lane & 15, fq = lane >> 4;
    LAS unsigned char* QT = lds; LAS unsigned char* KH = lds + 33792; LAS unsigned char* VS = lds + 70656; LAS unsigned char* ST = lds + 79872;
    const int b = bh >> 2, h = bh & 3, v0 = vs * 64;
    const bf16* QG = (const bf16*)(a.ws + WS_QG); const bf16* KHT = (const bf16*)(a.ws + WS_KHT); const bf16* VTG = (const bf16*)(a.ws + WS_VTG);
    const float* DG = (const float*)(a.ws + WS_DG); const bf16* OG = (const bf16*)(a.ws + WS_OG);
    f32x4 sacc[2][4];
#pragma unroll
    for (int i = 0; i < 2; ++i)
#pragma unroll
        for (int j = 0; j < 4; ++j) sacc[i][j] = (f32x4){0.f, 0.f, 0.f, 0.f};
    for (int i = tid; i < 33792 / 4; i += NTHR) ((LAS unsigned*)ST)[i] = 0u;
    const int tt = wid >> 1, vp = (wid & 1) * 2;
    v4u rqA[4], rkA[4], rvA, rqB[4], rkB[4], rvB; f32x4 dvA[2], dvB[2]; v2u ogA[2], ogB[2];
#define GI_LOADS_T(n_, S) do { const int token0_ = b * SEQL + (n_) * 64; const size_t unit_ = (size_t)((b * 64 + (n_)) * 4 + h); \
        _Pragma("unroll") for (int j = 0; j < 4; ++j) { const int idx = tid + j * NTHR; rq##S[j] = *(const v4u*)(QG + (size_t)(token0_ + (idx >> 5)) * 1024 + h * 256 + (idx & 31) * 8); } \
        _Pragma("unroll") for (int j = 0; j < 4; ++j) { const int idx = tid + j * NTHR; rk##S[j] = *(const v4u*)(KHT + (unit_ * 256 + (idx >> 3)) * 64 + (idx & 7) * 8); } \
        rv##S = *(const v4u*)(VTG + (unit_ * 512 + v0 + (tid >> 3)) * 64 + (tid & 7) * 8); } while (0)
#define GI_LOADS_D(n_, S) do { const size_t unit_ = (size_t)((b * 64 + (n_)) * 4 + h); \
        _Pragma("unroll") for (int kt = 0; kt < 2; ++kt) dv##S[kt] = *(const f32x4*)(DG + unit_ * 256 + 32 * wid + 16 * kt + 4 * fq); } while (0)
#define GI_LOADS_O(n_, S) do { const int token0_ = b * SEQL + (n_) * 64; \
        _Pragma("unroll") for (int v2 = 0; v2 < 2; ++v2) og##S[v2] = *(const v2u*)(OG + (size_t)(token0_ + tt * 16 + fr) * DMOD + h * 512 + v0 + (vp + v2) * 16 + 4 * fq); } while (0)
#define GI_LOADS(n_, S) do { GI_LOADS_T(n_, S); GI_LOADS_D(n_, S); GI_LOADS_O(n_, S); } while (0)
#define GI_STEP(n_, S) do { const int token0 = b * SEQL + (n_) * 64; \
        _Pragma("unroll") for (int j = 0; j < 4; ++j) { const int idx = tid + j * NTHR; *(LAS v4u*)(QT + (idx >> 5) * QPB + (idx & 31) * 16) = rq##S[j]; } \
        _Pragma("unroll") for (int j = 0; j < 4; ++j) { const int idx = tid + j * NTHR; *(LAS v4u*)(KH + (idx >> 3) * TPB + (idx & 7) * 16) = rk##S[j]; } \
        *(LAS v4u*)(VS + (tid >> 3) * TPB + (tid & 7) * 16) = rv##S; \
        const f32x4 dv0 = dv##S[0], dv1 = dv##S[1]; const v2u g0_ = og##S[0], g1_ = og##S[1]; const f32x4 og0 = (f32x4){blo(g0_.x), bhi(g0_.x), blo(g0_.y), bhi(g0_.y)}, og1 = (f32x4){blo(g1_.x), bhi(g1_.x), blo(g1_.y), bhi(g1_.y)}; \
        __syncthreads(); \
        GI_LOADS_T(((n_) + 2 < 64 ? (n_) + 2 : 63), S);     \
        { f32x4 acc0 = (f32x4){0.f, 0.f, 0.f, 0.f}, acc1 = acc0; bf16x8 Ya_, X0a_, X1a_, Yb_, X0b_, X1b_; \
              \
            _Pragma("unroll") for (int kk = 0; kk < 8; kk += 2) { \
                if (kk == 0) { Ya_ = ldfrag(QT + (tt * 16 + fr) * QPB + (8 * fq) * 2); X0a_ = ldfrag(ST + (vp * 16 + fr) * QPB + (8 * fq) * 2); X1a_ = ldfrag(ST + ((vp + 1) * 16 + fr) * QPB + (8 * fq) * 2); \
                               Yb_ = ldfrag(QT + (tt * 16 + fr) * QPB + (32 + 8 * fq) * 2); X0b_ = ldfrag(ST + (vp * 16 + fr) * QPB + (32 + 8 * fq) * 2); X1b_ = ldfrag(ST + ((vp + 1) * 16 + fr) * QPB + (32 + 8 * fq) * 2); } \
                __builtin_amdgcn_sched_barrier(0); \
                acc0 = __builtin_amdgcn_mfma_f32_16x16x32_bf16(X0a_, Ya_, acc0, 0, 0, 0); acc1 = __builtin_amdgcn_mfma_f32_16x16x32_bf16(X1a_, Ya_, acc1, 0, 0, 0); \
                __builtin_amdgcn_sched_barrier(0); \
                if (kk + 2 < 8) { Ya_ = ldfrag(QT + (tt * 16 + fr) * QPB + ((kk + 2) * 32 + 8 * fq) * 2); X0a_ = ldfrag(ST + (vp * 16 + fr) * QPB + ((kk + 2) * 32 + 8 * fq) * 2); X1a_ = ldfrag(ST + ((vp + 1) * 16 + fr) * QPB + ((kk + 2) * 32 + 8 * fq) * 2); } \
                __builtin_amdgcn_sched_barrier(0); \
                acc0 = __builtin_amdgcn_mfma_f32_16x16x32_bf16(X0b_, Yb_, acc0, 0, 0, 0); acc1 = __builtin_amdgcn_mfma_f32_16x16x32_bf16(X1b_, Yb_, acc1, 0, 0, 0); \
                __builtin_amdgcn_sched_barrier(0); \
                if (kk + 3 < 8) { Yb_ = ldfrag(QT + (tt * 16 + fr) * QPB + ((kk + 3) * 32 + 8 * fq) * 2); X0b_ = ldfrag(ST + (vp * 16 + fr) * QPB + ((kk + 3) * 32 + 8 * fq) * 2); X1b_ = ldfrag(ST + ((vp + 1) * 16 + fr) * QPB + ((kk + 3) * 32 + 8 * fq) * 2); } } \
            bf16* op = (bf16*)(a.ws + WS_T1) + (size_t)(token0 + tt * 16 + fr) * DMOD + h * 512 + v0 + vp * 16 + 4 * fq; \
            const f32x4 s0_ = og0 + acc0, s1_ = og1 + acc1; v2u w0_, w1_; w0_.x = pk2(s0_[0], s0_[1]); w0_.y = pk2(s0_[2], s0_[3]); w1_.x = pk2(s1_[0], s1_[1]); w1_.y = pk2(s1_[2], s1_[3]); \
            *(v2u*)op = w0_; *(v2u*)(op + 16) = w1_; } \
        GI_LOADS_O(((n_) + 2 < 64 ? (n_) + 2 : 63), S); \
        { bf16x8 Xk[2][2], Y0a_, Y1a_, Y0b_, Y1b_; \
            _Pragma("unroll") for (int kt = 0; kt < 2; ++kt) { Xk[kt][0] = ldfrag(KH + (32 * wid + 16 * kt + fr) * TPB + (8 * fq) * 2); Xk[kt][1] = ldfrag(KH + (32 * wid + 16 * kt + fr) * TPB + (32 + 8 * fq) * 2); } \
            Y0a_ = ldfrag(VS + (fr) * TPB + (8 * fq) * 2); Y1a_ = ldfrag(VS + (fr) * TPB + (32 + 8 * fq) * 2); Y0b_ = ldfrag(VS + (16 + fr) * TPB + (8 * fq) * 2); Y1b_ = ldfrag(VS + (16 + fr) * TPB + (32 + 8 * fq) * 2); \
            _Pragma("unroll") for (int v2 = 0; v2 < 4; v2 += 2) { \
                __builtin_amdgcn_sched_barrier(0); \
                _Pragma("unroll") for (int kt = 0; kt < 2; ++kt) { f32x4 s_ = sacc[kt][v2] * (kt ? dv1 : dv0); \
                    s_ = __builtin_amdgcn_mfma_f32_16x16x32_bf16(Xk[kt][0], Y0a_, s_, 0, 0, 0); s_ = __builtin_amdgcn_mfma_f32_16x16x32_bf16(Xk[kt][1], Y1a_, s_, 0, 0, 0); sacc[kt][v2] = s_; } \
                __builtin_amdgcn_sched_barrier(0); \
                if (v2 + 2 < 4) { Y0a_ = ldfrag(VS + ((v2 + 2) * 16 + fr) * TPB + (8 * fq) * 2); Y1a_ = ldfrag(VS + ((v2 + 2) * 16 + fr) * TPB + (32 + 8 * fq) * 2); } \
                __builtin_amdgcn_sched_barrier(0); \
                _Pragma("unroll") for (int kt = 0; kt < 2; ++kt) { f32x4 s_ = sacc[kt][v2 + 1] * (kt ? dv1 : dv0); \
                    s_ = __builtin_amdgcn_mfma_f32_16x16x32_bf16(Xk[kt][0], Y0b_, s_, 0, 0, 0); s_ = __builtin_amdgcn_mfma_f32_16x16x32_bf16(Xk[kt][1], Y1b_, s_, 0, 0, 0); sacc[kt][v2 + 1] = s_; } \
                __builtin_amdgcn_sched_barrier(0); \
                if (v2 + 3 < 4) { Y0b_ = ldfrag(VS + ((v2 + 3) * 16 + fr) * TPB + (8 * fq) * 2); Y1b_ = ldfrag(VS + ((v2 + 3) * 16 + fr) * TPB + (32 + 8 * fq) * 2); } } } \
        GI_LOADS_D(((n_) + 2 < 64 ? (n_) + 2 : 63), S); \
        __syncthreads(); \
        _Pragma("unroll") for (int kt = 0; kt < 2; ++kt) _Pragma("unroll") for (int v2 = 0; v2 < 4; ++v2) { v2u w; w.x = pk2(sacc[kt][v2][0], sacc[kt][v2][1]); w.y = pk2(sacc[kt][v2][2], sacc[kt][v2][3]); \
                *(LAS v2u*)(ST + (v2 * 16 + fr) * QPB + (32 * wid + 16 * kt + 4 * fq) * 2) = w; } } while (0)
    GI_LOADS(0, A); GI_LOADS(1, B);
#pragma unroll 1
    for (int n = 0; n < 64; n += 2) { GI_STEP(n, A); GI_STEP(n + 1, B); }
#undef GI_LOADS
#undef GI_LOADS_T
#undef GI_LOADS_D
#undef GI_LOADS_O
#undef GI_STEP
    __syncthreads();
}

__device__ __forceinline__ void phase_post(CArgs& a, int l, int gw, int NGW, int lane) {
    const bf16* P = (const bf16*)(a.ws + WS_P); const bf16* OG = (const bf16*)(a.ws + WS_T1); const bf16* OB = (const bf16*)(a.ws + WS_OB);
    bf16* OA = (bf16*)(a.ws + WS_OA); bf16* OBF = (bf16*)(a.ws + WS_OA) + DMOD;
    const float* dl = a.in[7] + (size_t)l * 256;
    const float s1 = wave_sum(dl[lane] * dl[64 + lane], lane), s2 = wave_sum(dl[128 + lane] * dl[192 + lane], lane);
    const float lam_init = 0.8f - 0.6f * expf(-0.3f * (float)l);
    const float lam = expf(s1) - expf(s2) + lam_init;
    const float oml = 1.0f - lam_init;
    const f32x4* gg = (const f32x4*)(a.in[6] + (size_t)l * 512 + lane * 8);
    const f32x4 gg0 = gg[0], gg1 = gg[1];
    const int hd = lane >> 2, sub = lane & 3;
    for (int row = gw; row < TOK; row += NGW) {
#pragma unroll
        for (int h = 0; h < 4; ++h) {
            const v4u ov_ = *(const v4u*)(OG + (size_t)row * DMOD + h * 512 + lane * 8);
            const f32x4 o0 = (f32x4){blo(ov_.x), bhi(ov_.x), blo(ov_.y), bhi(ov_.y)}, o1 = (f32x4){blo(ov_.z), bhi(ov_.z), blo(ov_.w), bhi(ov_.w)};
            const float ss = wave_sum((o0.x * o0.x + o0.y * o0.y) + (o0.z * o0.z + o0.w * o0.w) + (o1.x * o1.x + o1.y * o1.y) + (o1.z * o1.z + o1.w * o1.w), lane);
            const float rs = 1.0f / sqrtf(ss * (1.0f / 512.0f) + EPSN);
            const v4u ag = *(const v4u*)(P + (size_t)row * NPP + C_AG + h * 512 + lane * 8);
            v4u w;
            w.x = pk2(o0.x * rs * gg0.x * siluf(blo(ag.x)), o0.y * rs * gg0.y * siluf(bhi(ag.x)));
            w.y = pk2(o0.z * rs * gg0.z * siluf(blo(ag.y)), o0.w * rs * gg0.w * siluf(bhi(ag.y)));
            w.z = pk2(o1.x * rs * gg1.x * siluf(blo(ag.z)), o1.y * rs * gg1.y * siluf(bhi(ag.z)));
            w.w = pk2(o1.z * rs * gg1.z * siluf(blo(ag.w)), o1.w * rs * gg1.w * siluf(bhi(ag.w)));
            *(v4u*)(OA + (size_t)row * (2 * DMOD) + h * 512 + lane * 8) = w;
        }
    }
}

#ifdef PROBE_DOUBLE
constexpr int NPL = 7 + __builtin_popcount(PROBE_DOUBLE);
__device__ __forceinline__ int probe_k(int slot) { int s = 0; for (int k = 0; k < 7; ++k) { if (s == slot) return k; ++s; if ((PROBE_DOUBLE >> k) & 1) { if (s == slot) return k; ++s; } } return 6; }
#else
constexpr int NPL = 7;
#endif
constexpr int N_PHASES = 1 + NPL * DEPTH;
#ifndef PHMASK
#define PHMASK 0x1ff
#endif
__global__ void __launch_bounds__(NTHR, 2) mega_fwd(const Args args_) {
    extern __shared__ __attribute__((aligned(16))) unsigned char lds_raw[];
    LAS unsigned char* lds = (LAS unsigned char*)lds_raw;
    cg::grid_group grid = cg::this_grid();
    const int G = gridDim.x;
    const int wave0 = __builtin_amdgcn_readfirstlane((int)threadIdx.x >> 6);
    volatile LAS unsigned* MISC = (volatile LAS unsigned*)(lds + MISC_OFF);
    if (threadIdx.x < 32) MISC[threadIdx.x] = 0u;
    __syncthreads();
    { XcdBarrier b0 = xcd_barrier_post((unsigned*)(args_.ws) + CW_BAR, MISC + 8, (int)threadIdx.x); (void)b0; }
    grid.sync();
    const int ph_lo = args_.ph_lo;
    for (int ph = ph_lo; ; ++ph) {
        int lane_, wv_ = wave0, bx = blockIdx.x;
        asm volatile("v_mbcnt_lo_u32_b32 %0, -1, 0\n\tv_mbcnt_hi_u32_b32 %0, -1, %0" : "=v"(lane_));
        CArgs* ap = (CArgs*)__builtin_amdgcn_kernarg_segment_ptr();
        asm volatile("" : "+s"(wv_), "+s"(bx), "+s"(ap));
        CArgs& args = *ap;
#ifdef PROBE_SPIN
        if (bx == 0 && wv_ == 0 && lane_ == 0) {
            volatile LAS unsigned long long* T = (volatile LAS unsigned long long*)(lds + MISC_OFF + 80);
            const unsigned long long now = __builtin_amdgcn_s_memrealtime();
            if (T[2]) T[1] = T[1] + (now - T[0]);
            T[0] = now;
            const int kk_ = (ph == 0) ? 7 : (ph >= N_PHASES - 1) ? 8 : (ph - 1) % NPL;
            T[2] = (unsigned long long)((PROBE_SPIN >> kk_) & 1);
        }
#endif
        if (ph >= args.ph_hi) break;
        unsigned char* ws = args.ws;
#define PH_IDS() int ln_i; asm volatile("v_mbcnt_lo_u32_b32 %0, -1, 0\n\tv_mbcnt_hi_u32_b32 %0, -1, %0" : "=v"(ln_i)); const int tid = wv_ * 64 + ln_i, lane = ln_i, wave = wv_; const int gw = bx * NWAVES + wave, NGW = G * NWAVES; (void)tid; (void)lane; (void)gw; (void)NGW
        if (ph == 0) { PH_IDS(); if (PHMASK & 1) phase_weights(args, lds, gw, NGW, wave, lane);
            __syncthreads(); if (PHMASK & 2) phase_norm(args, lds, 0, gw, NGW, wave, lane); }
        else {
            const int l = (ph - 1) / NPL; int k = (ph - 1) % NPL;
#ifdef PROBE_DOUBLE
            k = probe_k(k);
#endif
            const bf16* WIN = (const bf16*)(ws + WS_WIN) + (size_t)l * NPP * DMOD;
            const bf16* WA = (const bf16*)(ws + WS_WABO) + (size_t)l * 3 * DMOD * DMOD; const bf16* WB = WA + (size_t)DMOD * DMOD; const bf16* WO = WB + (size_t)DMOD * DMOD;
            if (k == 0) { continue; }
            else if (k == 1) { PH_IDS(); if (PHMASK & 4) {
                if (l > 0) { alr_from_h(args, lds, l, gw, NGW, wave, lane); __syncthreads(); }
                pg8::Gemm g{(const bf16*)(ws + WS_H), WIN, TOK, NPP, DMOD}; pg8::StaticOrder S; S.init(TOK, NPP, G, bx);
                pg8::EpiProj E{(bf16*)(ws + WS_P)};
                pg8::gemm_phase<pg8::EpiProj, pg8::StaticOrder, true, true>(lds, g, S, E, tid); }
            } else if (k == 2) {
                PH_IDS();
                if (PHMASK & 8) for (int u = bx; u < 512; u += G) gla_intra_unit(args, l, lds, u >> 8, (u >> 2) & 63, u & 3, tid);
            } else if (k == 3) {
                PH_IDS();
                unsigned* qctr = (unsigned*)(args.ws) + CW_QUEUE + 64 * ph;
                volatile LAS unsigned* qw = (volatile LAS unsigned*)(lds + MISC_OFF) + 16;
#define QFETCH(dst) do { __syncthreads(); if (tid == 0) qw[0] = __hip_atomic_fetch_add(qctr, 1u, __ATOMIC_RELAXED, __HIP_MEMORY_SCOPE_AGENT); __syncthreads(); dst = __builtin_amdgcn_readfirstlane((int)qw[0]); } while (0)
                int idx; QFETCH(idx);
#ifdef PROBE_GLAT
                while (idx < 64) { unsigned long long t0_ = 0; if (idx == 0 && tid == 0) t0_ = __builtin_amdgcn_s_memrealtime();
                    gla_inter_unit(args, lds, idx >> 3, idx & 7, tid);
                    if (idx == 0 && tid == 0) atomicAdd((unsigned*)(args.ws) + 40960, (unsigned)(__builtin_amdgcn_s_memrealtime() - t0_));
                    QFETCH(idx); }
#else
                while (idx < 64) { gla_inter_unit(args, lds, idx >> 3, idx & 7, tid); QFETCH(idx); }
#endif
                int tid2 = tid; asm volatile("" : "+v"(tid2));
                float lam_, oml_;
                { const float* dl_ = args.in[7] + (size_t)l * 256; const int ln_ = tid2 & 63;
                  const float s1_ = wave_sum(dl_[ln_] * dl_[64 + ln_], ln_), s2_ = wave_sum(dl_[128 + ln_] * dl_[192 + ln_], ln_);
                  const float li_ = 0.8f - 0.6f * expf(-0.3f * (float)l); lam_ = expf(s1_) - expf(s2_) + li_; oml_ = 1.0f - li_; }
                while (idx < 64 + 128) {
                    const int aidx = idx - 64, r = aidx & 127, bh = r >> 2, qb = 15 - (4 * (aidx >> 7) + (r & 3));
                    const int b = bh >> 4, h = bh & 15;
                    const attn_body::bf16* Pp = (const attn_body::bf16*)(args.ws + WS_P);
#pragma unroll 1
                    for (int m = 0; m < 2; ++m)
                        attn_body::attn_unit<8>(b, qb, Pp + C_BQ + h * 128 + m * 64, Pp + C_BK + h * 128 + m * 64, Pp + C_BV + h * 128, (attn_body::bf16*)nullptr, (char*)lds_raw, tid2,
                                                m, lam_, oml_, Pp + C_BG + h * 128, args.in[8] + (size_t)l * 128, (attn_body::bf16*)(args.ws + WS_OA) + DMOD + h * 128);
                    __syncthreads(); if (tid2 == 0) qw[0] = __hip_atomic_fetch_add(qctr, 1u, __ATOMIC_RELAXED, __HIP_MEMORY_SCOPE_AGENT); __syncthreads(); idx = __builtin_amdgcn_readfirstlane((int)qw[0]);
                }
                while (idx < 64 + 128 + CV_UNITS) { if (l + 1 < DEPTH) convert_unit(args, lds, l + 1, idx - 64 - 128, wave, lane); QFETCH(idx); }
                int tid3 = tid; asm volatile("" : "+v"(tid3));
                while (idx < 64 + CV_UNITS + 512) {
                    const int aidx = idx - 64 - CV_UNITS, r = aidx & 127, bh = r >> 2, qb = 15 - (4 * (aidx >> 7) + (r & 3));
                    const int b = bh >> 4, h = bh & 15;
                    const attn_body::bf16* Pp = (const attn_body::bf16*)(args.ws + WS_P);
#pragma unroll 1
                    for (int m = 0; m < 2; ++m)
                        attn_body::attn_unit<8>(b, qb, Pp + C_BQ + h * 128 + m * 64, Pp + C_BK + h * 128 + m * 64, Pp + C_BV + h * 128, (attn_body::bf16*)nullptr, (char*)lds_raw, tid3,
                                                m, lam_, oml_, Pp + C_BG + h * 128, args.in[8] + (size_t)l * 128, (attn_body::bf16*)(args.ws + WS_OA) + DMOD + h * 128);
                    __syncthreads(); if (tid3 == 0) qw[0] = __hip_atomic_fetch_add(qctr, 1u, __ATOMIC_RELAXED, __HIP_MEMORY_SCOPE_AGENT); __syncthreads(); idx = __builtin_amdgcn_readfirstlane((int)qw[0]);
                }
#undef QFETCH
            } else if (k == 4) { PH_IDS(); if (PHMASK & 64) phase_post(args, l, gw, NGW, lane); }
            else if (k == 5) { PH_IDS(); if (PHMASK & 128) {
                pg8::Gemm g{(const bf16*)(ws + WS_OA), WA, TOK, DMOD, 2 * DMOD}; pg8::StaticOrder S; S.init(TOK, DMOD, G, bx);
                pg8::EpiMerge E{(const bf16*)(ws + WS_P), (bf16*)(ws + WS_MG)};
                pg8::gemm_phase<pg8::EpiMerge, pg8::StaticOrder, true, true>(lds, g, S, E, tid); }
            } else if (PHMASK & 256) {
                PH_IDS();
                pg8::Gemm g{(const bf16*)(ws + WS_MG), WO, TOK, DMOD, DMOD}; pg8::StaticOrder S; S.init(TOK, DMOD, G, bx);
                pg8::Unit u0; S.next(0, u0);
                unsigned* xc = (unsigned*)(ws) + CW_XCNT + ((l * 2) * 32 + u0.pm) * 64;
                pg8::RowStats st1{(float*)(ws + WS_PS), xc}, st2{(float*)(ws + WS_PS) + (size_t)TOK * 8, xc + 32 * 64};
                const float* gpo = args.in[2] + (size_t)l * DMOD; const float* gpr = args.in[1] + (size_t)((l + 1 < DEPTH) ? l + 1 : l) * DMOD;
                void* xb = (void*)(ws + WS_OUT);
                if (l == 0) { pg8::EpiOutFusedT<false, true> E{(const void*)args.in[0], xb, (bf16*)(ws + WS_H), gpo, gpr, st1, st2, 0};
                    pg8::gemm_phase<pg8::EpiOutFusedT<false, true>, pg8::StaticOrder, false, true>(lds, g, S, E, tid); }
                else if (l + 1 < DEPTH) { pg8::EpiOutFusedT<true, true> E{(const void*)xb, xb, (bf16*)(ws + WS_H), gpo, gpr, st1, st2, 0};
                    pg8::gemm_phase<pg8::EpiOutFusedT<true, true>, pg8::StaticOrder, false, true>(lds, g, S, E, tid); }
                else { pg8::EpiOutFusedT<true, false> E{(const void*)xb, (void*)args.out, (bf16*)(ws + WS_H), gpo, gpr, st1, st2, 1};
                    pg8::gemm_phase<pg8::EpiOutFusedT<true, false>, pg8::StaticOrder, false, true>(lds, g, S, E, tid); }
            }
        }
        { int l2_; asm volatile("v_mbcnt_lo_u32_b32 %0, -1, 0\n\tv_mbcnt_hi_u32_b32 %0, -1, %0" : "=v"(l2_));
          CArgs* ap2 = (CArgs*)__builtin_amdgcn_kernarg_segment_ptr(); asm volatile("" : "+s"(ap2));
          if (ph + 1 < ap2->ph_hi) { XcdBarrier b; b.bar = (unsigned*)(ap2->ws) + CW_BAR; b.x = xb_xcc_id(); b.st = (volatile LAS unsigned*)(lds + MISC_OFF) + 8; xcd_barrier(b, wave0 * 64 + l2_); } }
    }
#ifdef PROBE_GLAT
    { int ln_; asm volatile("v_mbcnt_lo_u32_b32 %0, -1, 0\n\tv_mbcnt_hi_u32_b32 %0, -1, %0" : "=v"(ln_));
      if (blockIdx.x == 0 && wave0 == 0 && ln_ == 0) { const unsigned w = __hip_atomic_load((unsigned*)(args_.ws) + 40960, __ATOMIC_RELAXED, __HIP_MEMORY_SCOPE_AGENT);
        const unsigned long long t0 = __builtin_amdgcn_s_memrealtime(); while (__builtin_amdgcn_s_memrealtime() - t0 < (unsigned long long)w) __builtin_amdgcn_s_sleep(32); } }
#endif
#ifdef PROBE_SPIN
    int ln_; asm volatile("v_mbcnt_lo_u32_b32 %0, -1, 0\n\tv_mbcnt_hi_u32_b32 %0, -1, %0" : "=v"(ln_));
    if (blockIdx.x == 0 && wave0 == 0 && ln_ == 0) {
        volatile LAS unsigned long long* T = (volatile LAS unsigned long long*)(lds + MISC_OFF + 80);
        const unsigned long long t0 = __builtin_amdgcn_s_memrealtime(), w = T[1];
        while (__builtin_amdgcn_s_memrealtime() - t0 < w) __builtin_amdgcn_s_sleep(32);
    }
#endif
}

extern "C" void kernel_launch(void* const* d_in, const int* in_sizes, int n_in, void* d_out, int out_size, void* d_ws, size_t ws_size, hipStream_t stream) {
    static int grid = 0;
    if (grid == 0) {
        if (n_in != 12 || in_sizes[0] != TOK * DMOD || out_size != TOK * DMOD || ws_size < WS_END) { fprintf(stderr, "kernel_launch: unexpected shapes (n_in %d, in0 %d, out %d, ws %zu)\n", n_in, n_in > 0 ? in_sizes[0] : -1, out_size, ws_size); grid = -1; return; }
        int dev = 0, cus = 0, per_cu = 0;
        if (hipGetDevice(&dev) != hipSuccess || hipDeviceGetAttribute(&cus, hipDeviceAttributeMultiprocessorCount, dev) != hipSuccess) { grid = -1; return; }
        if (hipFuncSetAttribute((const void*)mega_fwd, hipFuncAttributeMaxDynamicSharedMemorySize, LDS_BYTES) != hipSuccess) { fprintf(stderr, "kernel_launch: hipFuncSetAttribute failed\n"); grid = -1; return; }
        if (hipOccupancyMaxActiveBlocksPerMultiprocessor(&per_cu, (const void*)mega_fwd, NTHR, LDS_BYTES) != hipSuccess || per_cu < 1) { fprintf(stderr, "kernel_launch: occupancy query says %d\n", per_cu); per_cu = 1; }
        (void)hipGetLastError();
        grid = cus;
        if (grid != 256) { fprintf(stderr, "kernel_launch: built for a 256-CU device (row striping of the thin phases), found %d CUs; nothing launched\n", grid); grid = -1; return; }
    }
    if (grid < 0) return;
    if (hipMemsetAsync(d_ws, 0, CTL_ZERO_BYTES, stream) != hipSuccess) { fprintf(stderr, "kernel_launch: memset of the control words failed\n"); return; }
    Args a{};
    for (int i = 0; i < 12; ++i) a.in[i] = (const float*)d_in[i];
    a.out = (float*)d_out; a.ws = (unsigned char*)d_ws; a.ph_lo = 0; a.ph_hi = N_PHASES;
    void* kargs[] = {&a};
    hipError_t e = hipLaunchCooperativeKernel((const void*)mega_fwd, dim3(grid), dim3(NTHR), kargs, LDS_BYTES, stream);
    if (e != hipSuccess) fprintf(stderr, "kernel_launch: cooperative launch failed: %s (grid %d)\n", hipGetErrorString(e), grid);
}
```

```cpp
#include <hip/hip_runtime.h>
#include <hip/hip_cooperative_groups.h>
#include <cstdio>
#include <cstdint>
namespace pg8 {
#define PG8_LAS __attribute__((address_space(3)))
typedef unsigned short bf16_t;
typedef short bf16x8 __attribute__((ext_vector_type(8)));
typedef float f32x4 __attribute__((ext_vector_type(4)));
typedef unsigned u32x4 __attribute__((ext_vector_type(4)));
constexpr int BM = 256, BK = 64, HALF = 128, HTB = HALF * BK * 2  , STAGE_BYTES = 8 * HTB, NXCD = 8, WGM = 8;

__host__ __device__ __forceinline__ int lds_byte(int r, int c) { const int st = (r >> 4) * 2 + (c >> 5), rr = r & 15, cc = c & 31, ob = rr * 64 + cc * 2; return st * 1024 + (ob ^ (((ob >> 9) & 1) << 5)); }
__host__ __device__ __forceinline__ void stage_rc(int b, int& R, int& C) { const int st = b / 1024, sb = b % 1024, swz = sb ^ (((sb >> 9) & 1) << 5); R = (st >> 1) * 16 + swz / 64; C = (st & 1) * 32 + (swz % 64) / 2; }
__host__ __device__ __forceinline__ int perm32(int rho) { const int n = rho >> 4, i = rho & 15; return 8 * (i >> 2) + 4 * n + (i & 3); }

struct Unit { int pm, pn; };
struct Gemm { const bf16_t* A; const bf16_t* Bt; int M, N, K; };

struct StaticOrder {
    int nM, nN, nwg, G, c;
    __host__ __device__ void init(int M, int N, int G_, int c_) { nM = M / BM; nN = N / BM; nwg = nM * nN; G = G_; c = c_; }
    __host__ __device__ bool next(int i, Unit& u) const {
        const long L = (long)i * G + c; if (L >= nwg) return false;
        int wgid = (int)L; { const int q = nwg / NXCD, r = nwg % NXCD, xcd = wgid % NXCD, off = wgid / NXCD; wgid = (xcd < r ? xcd * (q + 1) : r * (q + 1) + (xcd - r) * q) + off; }
        const int nig = WGM * nN, gid = wgid / nig, fm = gid * WGM, gsz = (nM - fm) < WGM ? (nM - fm) : WGM;
        u.pm = fm + ((wgid % nig) % gsz); u.pn = (wgid % nig) / gsz; return true;
    }
    __device__ __forceinline__ void a_ready(const Unit&) const {}
    __device__ __forceinline__ void done(const Unit&) const {}
};

__device__ __forceinline__ unsigned cvt_pk_bf16(float lo, float hi) { unsigned r; asm volatile("v_cvt_pk_bf16_f32 %0, %1, %2" : "=v"(r) : "v"(lo), "v"(hi)); return r; }
constexpr int NP = 18432;
constexpr float QC2 = 0.125f * 1.4426950408889634f;
__device__ __forceinline__ float bflo(unsigned w) { return __uint_as_float(w << 16); }
__device__ __forceinline__ float bfhi(unsigned w) { return __uint_as_float(w & 0xffff0000u); }
__device__ __forceinline__ float sigm(float x) { return __builtin_amdgcn_rcpf(1.0f + __builtin_amdgcn_exp2f(-1.4426950408889634f * x)); }
struct EpiProj {
    static constexpr bool PERM = true, AFTER_DRAIN = false, HAS_MID = false;
    bf16_t* O;
    __device__ __forceinline__ void operator()(const f32x4 (&acc)[2][2][4][2], const Unit& u, int wr, int wc, int fr, int fq) const {
        const int row0 = u.pm * BM + wr * 64 + fr; const int colt = u.pn * BM;
        float sc = 1.f; if (colt < 1024) sc = 0.0625f; else if (colt >= 6144 && colt < 8192) sc = QC2;
        const int col0 = colt + wc * 32 + 8 * fq;
#pragma unroll
        for (int ai = 0; ai < 2; ++ai)
#pragma unroll
            for (int m = 0; m < 4; ++m) { bf16_t* rowp = O + (size_t)(row0 + ai * HALF + m * 16) * NP + col0;
#pragma unroll
                for (int bj = 0; bj < 2; ++bj) { const f32x4 v0 = acc[ai][bj][m][0] * sc, v1 = acc[ai][bj][m][1] * sc;
                    u32x4 w; w.x = cvt_pk_bf16(v0[0], v0[1]); w.y = cvt_pk_bf16(v0[2], v0[3]); w.z = cvt_pk_bf16(v1[0], v1[1]); w.w = cvt_pk_bf16(v1[2], v1[3]);
                    *(u32x4*)(rowp + bj * HALF) = w; } }
    }
};
struct EpiGateA {
    static constexpr bool PERM = true, AFTER_DRAIN = false, HAS_MID = false;
    const bf16_t* P; float* T1;
    __device__ __forceinline__ void operator()(const f32x4 (&acc)[2][2][4][2], const Unit& u, int wr, int wc, int fr, int fq) const {
        const int row0 = u.pm * BM + wr * 64 + fr; const int col0 = u.pn * BM + wc * 32 + 8 * fq;
#pragma unroll
        for (int ai = 0; ai < 2; ++ai)
#pragma unroll
            for (int m = 0; m < 4; ++m) { const size_t row = (size_t)(row0 + ai * HALF + m * 16);
#pragma unroll
                for (int bj = 0; bj < 2; ++bj) { const int col = col0 + bj * HALF;
                    const u32x4 g = *(const u32x4*)(P + row * NP + 14336 + col);
                    f32x4 o0, o1; const f32x4 a0 = acc[ai][bj][m][0], a1 = acc[ai][bj][m][1];
                    o0[0] = a0[0] * sigm(bflo(g.x)); o0[1] = a0[1] * sigm(bfhi(g.x)); o0[2] = a0[2] * sigm(bflo(g.y)); o0[3] = a0[3] * sigm(bfhi(g.y));
                    o1[0] = a1[0] * sigm(bflo(g.z)); o1[1] = a1[1] * sigm(bfhi(g.z)); o1[2] = a1[2] * sigm(bflo(g.w)); o1[3] = a1[3] * sigm(bfhi(g.w));
                    float* tp = T1 + row * 2048 + col; *(f32x4*)tp = o0; *(f32x4*)(tp + 4) = o1; } }
    }
};
struct EpiGateB {
    static constexpr bool PERM = true, AFTER_DRAIN = false, HAS_MID = false;
    const bf16_t* P; const float* T1; bf16_t* MG;
    __device__ __forceinline__ void operator()(const f32x4 (&acc)[2][2][4][2], const Unit& u, int wr, int wc, int fr, int fq) const {
        const int row0 = u.pm * BM + wr * 64 + fr; const int col0 = u.pn * BM + wc * 32 + 8 * fq;
#pragma unroll
        for (int ai = 0; ai < 2; ++ai)
#pragma unroll
            for (int m = 0; m < 4; ++m) { const size_t row = (size_t)(row0 + ai * HALF + m * 16);
#pragma unroll
                for (int bj = 0; bj < 2; ++bj) { const int col = col0 + bj * HALF;
                    const u32x4 g = *(const u32x4*)(P + row * NP + 16384 + col);
                    const float* tp = T1 + row * 2048 + col; const f32x4 t0 = *(const f32x4*)tp, t1 = *(const f32x4*)(tp + 4);
                    f32x4 o0, o1; const f32x4 a0 = acc[ai][bj][m][0], a1 = acc[ai][bj][m][1];
                    o0[0] = t0[0] + a0[0] * sigm(bflo(g.x)); o0[1] = t0[1] + a0[1] * sigm(bfhi(g.x)); o0[2] = t0[2] + a0[2] * sigm(bflo(g.y)); o0[3] = t0[3] + a0[3] * sigm(bfhi(g.y));
                    o1[0] = t1[0] + a1[0] * sigm(bflo(g.z)); o1[1] = t1[1] + a1[1] * sigm(bfhi(g.z)); o1[2] = t1[2] + a1[2] * sigm(bflo(g.w)); o1[3] = t1[3] + a1[3] * sigm(bfhi(g.w));
                    u32x4 w; w.x = cvt_pk_bf16(o0[0], o0[1]); w.y = cvt_pk_bf16(o0[2], o0[3]); w.z = cvt_pk_bf16(o1[0], o1[1]); w.w = cvt_pk_bf16(o1[2], o1[3]);
                    *(u32x4*)(MG + row * 2048 + col) = w; } }
    }
};
struct EpiOut {
    static constexpr bool PERM = true, AFTER_DRAIN = false, HAS_MID = false;
    bf16_t* OUT; float* PS;
    __device__ __forceinline__ void operator()(const f32x4 (&acc)[2][2][4][2], const Unit& u, int wr, int wc, int fr, int fq) const {
        const int row0 = u.pm * BM + wr * 64 + fr; const int col0 = u.pn * BM + wc * 32 + 8 * fq;
#pragma unroll
        for (int ai = 0; ai < 2; ++ai)
#pragma unroll
            for (int m = 0; m < 4; ++m) { const size_t row = (size_t)(row0 + ai * HALF + m * 16); float s = 0.f;
#pragma unroll
                for (int bj = 0; bj < 2; ++bj) { const f32x4 a0 = acc[ai][bj][m][0], a1 = acc[ai][bj][m][1];
                    { u32x4 w; w.x = cvt_pk_bf16(a0[0], a0[1]); w.y = cvt_pk_bf16(a0[2], a0[3]); w.z = cvt_pk_bf16(a1[0], a1[1]); w.w = cvt_pk_bf16(a1[2], a1[3]); *(u32x4*)(OUT + row * 2048 + col0 + bj * HALF) = w; }
                    s += (a0[0] * a0[0] + a0[1] * a0[1]) + (a0[2] * a0[2] + a0[3] * a0[3]) + (a1[0] * a1[0] + a1[1] * a1[1]) + (a1[2] * a1[2] + a1[3] * a1[3]); }
                s += __uint_as_float(__builtin_amdgcn_ds_bpermute((((fq ^ 1) << 4) | fr) << 2, __float_as_uint(s))); s += __uint_as_float(__builtin_amdgcn_ds_bpermute((((fq ^ 2) << 4) | fr) << 2, __float_as_uint(s)));
                if (fq == 0) PS[row * 32 + u.pn * 4 + wc] = s; }
    }
};
struct EpiMerge {
    static constexpr bool PERM = true, AFTER_DRAIN = false, HAS_MID = true;
    const bf16_t* P; bf16_t* MG;
    __device__ __forceinline__ void mid(f32x4 (&acc)[2][2][4][2], const Unit& u, int wr, int wc, int fr, int fq) const {
        int row0 = u.pm * BM + wr * 64 + fr; int col0 = u.pn * BM + wc * 32 + 8 * fq;
        asm volatile("" : "+v"(row0), "+v"(col0));
#define RT_(x, y) ((1.0f + __builtin_amdgcn_exp2f(-1.4426950408889634f * (y))) * __builtin_amdgcn_rcpf(1.0f + __builtin_amdgcn_exp2f(-1.4426950408889634f * (x))))
#pragma unroll
        for (int ai = 0; ai < 2; ++ai)
#pragma unroll
            for (int mp = 0; mp < 4; mp += 2) {
                u32x4 ga[2][2], gb[2][2];
#pragma unroll
                for (int mm = 0; mm < 2; ++mm)
#pragma unroll
                    for (int bj = 0; bj < 2; ++bj) { const size_t row = (size_t)(row0 + ai * HALF + (mp + mm) * 16); const int col = col0 + bj * HALF;
                        ga[mm][bj] = *(const u32x4*)(P + row * NP + 14336 + col); gb[mm][bj] = *(const u32x4*)(P + row * NP + 16384 + col); }
#pragma unroll
                for (int mm = 0; mm < 2; ++mm)
#pragma unroll
                    for (int bj = 0; bj < 2; ++bj) { const int m = mp + mm; const u32x4 xa = ga[mm][bj], xb = gb[mm][bj];
                        f32x4 a0 = acc[ai][bj][m][0], a1 = acc[ai][bj][m][1];
                        a0[0] *= RT_(bflo(xa.x), bflo(xb.x)); a0[1] *= RT_(bfhi(xa.x), bfhi(xb.x)); a0[2] *= RT_(bflo(xa.y), bflo(xb.y)); a0[3] *= RT_(bfhi(xa.y), bfhi(xb.y));
                        a1[0] *= RT_(bflo(xa.z), bflo(xb.z)); a1[1] *= RT_(bfhi(xa.z), bfhi(xb.z)); a1[2] *= RT_(bflo(xa.w), bflo(xb.w)); a1[3] *= RT_(bfhi(xa.w), bfhi(xb.w));
                        acc[ai][bj][m][0] = a0; acc[ai][bj][m][1] = a1; }
                asm volatile("" ::: "memory"); }
#undef RT_
    }
    __device__ __forceinline__ void operator()(const f32x4 (&acc)[2][2][4][2], const Unit& u, int wr, int wc, int fr, int fq) const {
        const int row0 = u.pm * BM + wr * 64 + fr; const int col0 = u.pn * BM + wc * 32 + 8 * fq;
#pragma unroll
        for (int ai = 0; ai < 2; ++ai) {
            u32x4 gv[4][2];
#pragma unroll
            for (int m = 0; m < 4; ++m)
#pragma unroll
                for (int bj = 0; bj < 2; ++bj) gv[m][bj] = *(const u32x4*)(P + (size_t)(row0 + ai * HALF + m * 16) * NP + 16384 + col0 + bj * HALF);
#pragma unroll
            for (int m = 0; m < 4; ++m) { const size_t row = (size_t)(row0 + ai * HALF + m * 16);
#pragma unroll
                for (int bj = 0; bj < 2; ++bj) { const int col = col0 + bj * HALF; const u32x4 g = gv[m][bj];
                    const f32x4 a0 = acc[ai][bj][m][0], a1 = acc[ai][bj][m][1];
                    u32x4 w; w.x = cvt_pk_bf16(a0[0] * sigm(bflo(g.x)), a0[1] * sigm(bfhi(g.x))); w.y = cvt_pk_bf16(a0[2] * sigm(bflo(g.y)), a0[3] * sigm(bfhi(g.y)));
                    w.z = cvt_pk_bf16(a1[0] * sigm(bflo(g.z)), a1[1] * sigm(bfhi(g.z))); w.w = cvt_pk_bf16(a1[2] * sigm(bflo(g.w)), a1[3] * sigm(bfhi(g.w)));
                    *(u32x4*)(MG + row * 2048 + col) = w; } }
            asm volatile("" ::: "memory"); }
    }
};
struct RowStats {
    float* xbuf;
    unsigned* cnt;
    __device__ __forceinline__ void run(const f32x4 (&v)[2][2][4][2], const Unit& u, int wr, int wc, int fr, int fq, PG8_LAS unsigned char* lds, int wid, int lane) const {
        PG8_LAS float* Pp = (PG8_LAS float*)lds;
        PG8_LAS float* S = (PG8_LAS float*)(lds + 4096);
#pragma unroll
        for (int ai = 0; ai < 2; ++ai)
#pragma unroll
            for (int m = 0; m < 4; ++m) {
                float s = 0.f;
#pragma unroll
                for (int bj = 0; bj < 2; ++bj)
#pragma unroll
                    for (int n = 0; n < 2; ++n) { const f32x4 x = v[ai][bj][m][n]; s += (x[0] * x[0] + x[1] * x[1]) + (x[2] * x[2] + x[3] * x[3]); }
                s += __uint_as_float(__builtin_amdgcn_ds_bpermute((((fq ^ 1) << 4) | fr) << 2, __float_as_uint(s)));
                s += __uint_as_float(__builtin_amdgcn_ds_bpermute((((fq ^ 2) << 4) | fr) << 2, __float_as_uint(s)));
                if (fq == 0) Pp[(ai * HALF + wr * 64 + m * 16 + fr) * 4 + wc] = s;
            }
        asm volatile("s_waitcnt lgkmcnt(0)" ::: "memory"); __builtin_amdgcn_s_barrier(); asm volatile("" ::: "memory");
        const int row = wid * 32 + (lane & 31);
        if (lane < 32) {
            const float tot = (Pp[row * 4 + 0] + Pp[row * 4 + 1]) + (Pp[row * 4 + 2] + Pp[row * 4 + 3]);
            __hip_atomic_store(xbuf + (size_t)(u.pm * BM + row) * 8 + u.pn, tot, __ATOMIC_RELAXED, __HIP_MEMORY_SCOPE_AGENT);
        }
        asm volatile("s_waitcnt vmcnt(0)" ::: "memory");
        if (lane == 0) __hip_atomic_fetch_add(cnt, 1u, __ATOMIC_RELAXED, __HIP_MEMORY_SCOPE_AGENT);
        if (wid == 0) {
            while ((unsigned)__builtin_amdgcn_readfirstlane(__hip_atomic_load(cnt, __ATOMIC_RELAXED, __HIP_MEMORY_SCOPE_AGENT)) < 64u) __builtin_amdgcn_s_sleep(2);
            __builtin_amdgcn_fence(__ATOMIC_ACQUIRE, "agent");
        }
        asm volatile("s_waitcnt vmcnt(0) lgkmcnt(0)" ::: "memory"); __builtin_amdgcn_s_barrier(); asm volatile("" ::: "memory");
        if (lane < 32) {
            const float* slot = xbuf + (size_t)(u.pm * BM + row) * 8;
            float v8[8];
#pragma unroll
            for (int t = 0; t < 8; ++t) v8[t] = __hip_atomic_load(slot + t, __ATOMIC_RELAXED, __HIP_MEMORY_SCOPE_AGENT);
            const float q = ((v8[0] + v8[1]) + (v8[2] + v8[3])) + ((v8[4] + v8[5]) + (v8[6] + v8[7]));
            S[row] = 1.0f / sqrtf(q * (1.0f / 2048.0f) + 1e-6f);
        }
        asm volatile("s_waitcnt lgkmcnt(0)" ::: "memory"); __builtin_amdgcn_s_barrier(); asm volatile("" ::: "memory");
    }
};
template <bool XIN_BF, bool XOUT_BF> struct EpiOutFusedT {
    static constexpr bool PERM = true, AFTER_DRAIN = true, HAS_MID = false;
    const void* xprev; void* xout; bf16_t* H; const float* gpost; const float* gpre; RowStats st1, st2; int last;
    __device__ __forceinline__ void fused(f32x4 (&acc)[2][2][4][2], const Unit& u, int wr, int wc, int fr, int fq, PG8_LAS unsigned char* lds, int wid, int lane) const {
        const PG8_LAS float* S = (const PG8_LAS float*)(lds + 4096);
        const int col0 = u.pn * BM + wc * 32 + 8 * fq;
        const float* xpf = (const float*)xprev; const bf16_t* xpb = (const bf16_t*)xprev; float* xof = (float*)xout; bf16_t* xob = (bf16_t*)xout;
        f32x4 pre[XIN_BF ? 1 : 4][2][2]; u32x4 preb[XIN_BF ? 4 : 1][2];
#pragma unroll
        for (int m = 0; m < 4; ++m) { const size_t off = (size_t)(u.pm * BM + wr * 64 + m * 16 + fr) * 2048 + col0;
#pragma unroll
            for (int bj = 0; bj < 2; ++bj) {
                if constexpr (XIN_BF) preb[m][bj] = *(const u32x4*)(xpb + off + bj * HALF);
                else { pre[m][bj][0] = *(const f32x4*)(xpf + off + bj * HALF); pre[m][bj][1] = *(const f32x4*)(xpf + off + bj * HALF + 4); } } }
        st1.run(acc, u, wr, wc, fr, fq, lds, wid, lane);
        {
            f32x4 g[2][2];
#pragma unroll
            for (int bj = 0; bj < 2; ++bj) { g[bj][0] = *(const f32x4*)(gpost + col0 + bj * HALF); g[bj][1] = *(const f32x4*)(gpost + col0 + bj * HALF + 4); }
#pragma unroll
            for (int ai = 0; ai < 2; ++ai) {
                if (ai == 1) {
#pragma unroll
                    for (int m = 0; m < 4; ++m) { const size_t off = (size_t)(u.pm * BM + HALF + wr * 64 + m * 16 + fr) * 2048 + col0;
#pragma unroll
                        for (int bj = 0; bj < 2; ++bj) {
                            if constexpr (XIN_BF) preb[m][bj] = *(const u32x4*)(xpb + off + bj * HALF);
                            else { pre[m][bj][0] = *(const f32x4*)(xpf + off + bj * HALF); pre[m][bj][1] = *(const f32x4*)(xpf + off + bj * HALF + 4); } } }
                }
#pragma unroll
                for (int m = 0; m < 4; ++m) { const int r = ai * HALF + wr * 64 + m * 16 + fr; const float rs = S[r]; const size_t off = (size_t)(u.pm * BM + r) * 2048 + col0;
#pragma unroll
                    for (int bj = 0; bj < 2; ++bj) {
                        f32x4 b0, b1;
                        if constexpr (XIN_BF) { const u32x4 w = preb[m][bj]; b0 = (f32x4){bflo(w.x), bfhi(w.x), bflo(w.y), bfhi(w.y)}; b1 = (f32x4){bflo(w.z), bfhi(w.z), bflo(w.w), bfhi(w.w)}; }
                        else { b0 = pre[m][bj][0]; b1 = pre[m][bj][1]; }
                        const f32x4 x0 = b0 + acc[ai][bj][m][0] * rs * g[bj][0], x1 = b1 + acc[ai][bj][m][1] * rs * g[bj][1];
                        acc[ai][bj][m][0] = x0; acc[ai][bj][m][1] = x1;
                        if constexpr (XOUT_BF) { u32x4 w; w.x = cvt_pk_bf16(x0[0], x0[1]); w.y = cvt_pk_bf16(x0[2], x0[3]); w.z = cvt_pk_bf16(x1[0], x1[1]); w.w = cvt_pk_bf16(x1[2], x1[3]); *(u32x4*)(xob + off + bj * HALF) = w; }
                        else { *(f32x4*)(xof + off + bj * HALF) = x0; *(f32x4*)(xof + off + bj * HALF + 4) = x1; } }
                    asm volatile("" : "+v"(acc[ai][0][m][0]), "+v"(acc[ai][0][m][1]), "+v"(acc[ai][1][m][0]), "+v"(acc[ai][1][m][1])); }
                asm volatile("" ::: "memory");
            }
        }
        if (last) return;
        asm volatile("s_waitcnt lgkmcnt(0)" ::: "memory"); __builtin_amdgcn_s_barrier(); asm volatile("" ::: "memory");
        st2.run(acc, u, wr, wc, fr, fq, lds, wid, lane);
        {
            f32x4 g[2][2];
#pragma unroll
            for (int bj = 0; bj < 2; ++bj) { g[bj][0] = *(const f32x4*)(gpre + col0 + bj * HALF); g[bj][1] = *(const f32x4*)(gpre + col0 + bj * HALF + 4); }
#pragma unroll
            for (int ai = 0; ai < 2; ++ai)
#pragma unroll
                for (int m = 0; m < 4; ++m) { const int r = ai * HALF + wr * 64 + m * 16 + fr; const float rs = S[r]; const size_t off = (size_t)(u.pm * BM + r) * 2048 + col0;
#pragma unroll
                    for (int bj = 0; bj < 2; ++bj) { const f32x4 h0 = acc[ai][bj][m][0] * rs * g[bj][0], h1 = acc[ai][bj][m][1] * rs * g[bj][1];
                        u32x4 w; w.x = cvt_pk_bf16(h0[0], h0[1]); w.y = cvt_pk_bf16(h0[2], h0[3]); w.z = cvt_pk_bf16(h1[0], h1[1]); w.w = cvt_pk_bf16(h1[2], h1[3]);
                        *(u32x4*)(H + off + bj * HALF) = w; } }
        }
    }
};
template <class Epi, class Sched, bool ALIGN_EPI = false, bool SP2 = false>
__device__ __forceinline__ void gemm_phase(PG8_LAS unsigned char* lds, const Gemm g, const Sched& S, const Epi& E, const int tid) {
    const int wid = __builtin_amdgcn_readfirstlane(tid >> 6), lane = tid & 63, wr = wid >> 2, wc = wid & 3, fr = lane & 15, fq = lane >> 4;
    const int K = g.K, nt = K / BK;
    unsigned voffA[2], voffB[2];
#pragma unroll
    for (int i = 0; i < 2; ++i) { int R, C; stage_rc(tid * 16 + i * 8192, R, C); const int Rb = Epi::PERM ? ((R & ~31) + perm32(R & 31)) : R;
        voffA[i] = (unsigned)(R * K + C) * 2u; voffB[i] = (unsigned)(Rb * K + C) * 2u; }
    const size_t kstep = (size_t)(BK * 2);
    const size_t hstep = (size_t)HALF * K * 2;
    const size_t tstep = 2 * hstep;
    const unsigned ldsw = (unsigned)wid * 1024u;
    const int aoff = lds_byte(wr * 64 + fr, fq * 8), boff = lds_byte(wc * 32 + fr, fq * 8);
#define PG8_SA(b, h) (((b) * 2 + (h)) * HTB)
#define PG8_SB(b, h) ((4 + (b) * 2 + (h)) * HTB)
#define PG8_STAGE(bufoff, gbase, voff) do { _Pragma("unroll") for (int _i = 0; _i < 2; ++_i) \
        __builtin_amdgcn_global_load_lds((const unsigned*)((const char*)(gbase) + (voff)[_i]), (PG8_LAS unsigned*)(lds + (bufoff) + ldsw + _i * 8192), 16, 0, 0); } while (0)
#define PG8_LDA(dst, b, h) do { _Pragma("unroll") for (int m = 0; m < 4; ++m) _Pragma("unroll") for (int k = 0; k < 2; ++k) dst[m][k] = *(const PG8_LAS bf16x8*)(lds + PG8_SA(b, h) + aoff + m * 2048 + k * 1024); } while (0)
#define PG8_LDB(dst, b, h) do { _Pragma("unroll") for (int n = 0; n < 2; ++n) _Pragma("unroll") for (int k = 0; k < 2; ++k) dst[n][k] = *(const PG8_LAS bf16x8*)(lds + PG8_SB(b, h) + boff + n * 2048 + k * 1024); } while (0)
#define PG8_MMA(ai, bj, At, Bt) do { __builtin_amdgcn_s_setprio(1); _Pragma("unroll") for (int m = 0; m < 4; ++m) _Pragma("unroll") for (int n = 0; n < 2; ++n) _Pragma("unroll") for (int k = 0; k < 2; ++k) \
        acc[ai][bj][m][n] = __builtin_amdgcn_mfma_f32_16x16x32_bf16(Bt[n][k], At[m][k], acc[ai][bj][m][n], 0, 0, 0); __builtin_amdgcn_s_setprio(0); } while (0)
#define PG8_WAIT_V(n) asm volatile("s_waitcnt vmcnt(" #n ")" ::: "memory")
#define PG8_WAIT_L(n) asm volatile("s_waitcnt lgkmcnt(" #n ")" ::: "memory")
#define PG8_BAR __builtin_amdgcn_s_barrier()
#define PG8_SCHED __builtin_amdgcn_sched_barrier(0)
    Unit cur, nxt; int ui = 0;
    if (!S.next(0, cur)) return;
    f32x4 acc[2][2][4][2];
#pragma unroll
    for (int a = 0; a < 2; ++a)
#pragma unroll
        for (int b = 0; b < 2; ++b)
#pragma unroll
            for (int m = 0; m < 4; ++m)
#pragma unroll
                for (int n = 0; n < 2; ++n) acc[a][b][m][n] = (f32x4){0.f, 0.f, 0.f, 0.f};
    bf16x8 At[4][2], B0[2][2], B1[2][2];
    const char* cA = (const char*)g.A + (size_t)cur.pm * tstep; const char* cB = (const char*)g.Bt + (size_t)cur.pn * tstep;
    S.a_ready(cur);
    if constexpr (SP2) {
        PG8_STAGE(PG8_SB(0, 0), cB, voffB); PG8_STAGE(PG8_SB(0, 1), cB + hstep, voffB); PG8_STAGE(PG8_SA(0, 0), cA, voffA); PG8_STAGE(PG8_SA(0, 1), cA + hstep, voffA);
        if (wr == 1) PG8_BAR;
        PG8_WAIT_V(2); PG8_BAR;
        PG8_STAGE(PG8_SB(1, 0), cB + kstep, voffB); PG8_STAGE(PG8_SA(1, 0), cA + kstep, voffA); PG8_STAGE(PG8_SB(1, 1), cB + hstep + kstep, voffB);
        PG8_WAIT_V(6); PG8_BAR;
    } else {
        PG8_STAGE(PG8_SB(0, 0), cB, voffB); PG8_STAGE(PG8_SA(0, 0), cA, voffA); PG8_STAGE(PG8_SB(0, 1), cB + hstep, voffB); PG8_STAGE(PG8_SA(0, 1), cA + hstep, voffA);
        if (wr == 1) PG8_BAR;
        PG8_WAIT_V(4); PG8_BAR;
        PG8_STAGE(PG8_SB(1, 0), cB + kstep, voffB); PG8_STAGE(PG8_SA(1, 0), cA + kstep, voffA); PG8_STAGE(PG8_SB(1, 1), cB + hstep + kstep, voffB);
        PG8_WAIT_V(6); PG8_BAR;
    }
    for (;;) {
        const bool has_next = S.next(ui + 1, nxt);
        const char* nA = has_next ? (const char*)g.A + (size_t)nxt.pm * tstep : cA; const char* nB = has_next ? (const char*)g.Bt + (size_t)nxt.pn * tstep : cB;
        for (int t = 0; t < nt; t += 2) {
            if constexpr (Epi::HAS_MID) { if (t == (nt >> 1)) E.mid(acc, cur, wr, wc, fr, fq); }
            const bool last = (t == nt - 2);
            const char* a1 = cA + (size_t)(t + 1) * kstep;
            const char* a2 = last ? nA : cA + (size_t)(t + 2) * kstep; const char* b2 = last ? nB : cB + (size_t)(t + 2) * kstep;
            const char* a3 = a2 + kstep; const char* b3 = b2 + kstep;
            if (last && has_next) S.a_ready(nxt);
            if constexpr (SP2) {
            PG8_LDB(B0, 0, 0); PG8_LDB(B1, 0, 1); PG8_SCHED; PG8_LDA(At, 0, 0); PG8_STAGE(PG8_SA(1, 1), a1 + hstep, voffA);
            PG8_WAIT_V(8); PG8_WAIT_L(0); PG8_BAR; PG8_MMA(0, 0, At, B0); PG8_MMA(0, 1, At, B1); PG8_BAR; PG8_SCHED;
            PG8_LDA(At, 0, 1); PG8_STAGE(PG8_SB(0, 0), b2, voffB); PG8_STAGE(PG8_SB(0, 1), b2 + hstep, voffB); PG8_STAGE(PG8_SA(0, 0), a2, voffA);
            PG8_WAIT_V(8); PG8_WAIT_L(0); PG8_BAR; PG8_MMA(1, 0, At, B0); PG8_MMA(1, 1, At, B1); PG8_BAR; PG8_SCHED;
            PG8_LDB(B0, 1, 0); PG8_LDB(B1, 1, 1); PG8_SCHED; PG8_LDA(At, 1, 0); PG8_STAGE(PG8_SA(0, 1), a2 + hstep, voffA);
            PG8_WAIT_V(8); PG8_WAIT_L(0); PG8_BAR; PG8_MMA(0, 0, At, B0); PG8_MMA(0, 1, At, B1); PG8_BAR; PG8_SCHED;
            PG8_LDA(At, 1, 1); PG8_STAGE(PG8_SB(1, 0), b3, voffB); PG8_STAGE(PG8_SB(1, 1), b3 + hstep, voffB); PG8_STAGE(PG8_SA(1, 0), a3, voffA);
            PG8_WAIT_V(8); PG8_WAIT_L(0); PG8_BAR; PG8_MMA(1, 0, At, B0); PG8_MMA(1, 1, At, B1); PG8_BAR; PG8_SCHED;
            } else {
            PG8_LDB(B0, 0, 0); PG8_SCHED; PG8_LDA(At, 0, 0); PG8_STAGE(PG8_SA(1, 1), a1 + hstep, voffA);
            PG8_WAIT_L(8); PG8_BAR; PG8_WAIT_L(0); PG8_MMA(0, 0, At, B0); PG8_BAR; PG8_SCHED;
            PG8_LDB(B1, 0, 1); PG8_STAGE(PG8_SB(0, 0), b2, voffB);
            PG8_BAR; PG8_WAIT_L(0); PG8_MMA(0, 1, At, B1); PG8_BAR;
            PG8_LDA(At, 0, 1); PG8_STAGE(PG8_SA(0, 0), a2, voffA);
            PG8_BAR; PG8_WAIT_L(0); PG8_MMA(1, 0, At, B0); PG8_BAR; PG8_SCHED;
            PG8_STAGE(PG8_SB(0, 1), b2 + hstep, voffB);
            PG8_WAIT_V(6); PG8_BAR; PG8_MMA(1, 1, At, B1); PG8_BAR;
            PG8_LDB(B0, 1, 0); PG8_SCHED; PG8_LDA(At, 1, 0); PG8_STAGE(PG8_SA(0, 1), a2 + hstep, voffA);
            PG8_WAIT_L(8); PG8_BAR; PG8_WAIT_L(0); PG8_MMA(0, 0, At, B0); PG8_BAR; PG8_SCHED;
            PG8_LDB(B1, 1, 1); PG8_STAGE(PG8_SB(1, 0), b3, voffB);
            PG8_BAR; PG8_WAIT_L(0); PG8_MMA(0, 1, At, B1); PG8_BAR;
            PG8_LDA(At, 1, 1); PG8_STAGE(PG8_SA(1, 0), a3, voffA);
            PG8_BAR; PG8_WAIT_L(0); PG8_MMA(1, 0, At, B0); PG8_BAR; PG8_SCHED;
            PG8_STAGE(PG8_SB(1, 1), b3 + hstep, voffB);
            PG8_WAIT_V(6); PG8_BAR; PG8_MMA(1, 1, At, B1); PG8_BAR;
            }
        }
        if constexpr (ALIGN_EPI) { if (wr == 0) PG8_BAR; }
        if constexpr (!Epi::AFTER_DRAIN) { E(acc, cur, wr, wc, fr, fq); S.done(cur); }
        if (!has_next) break;
#pragma unroll
        for (int a = 0; a < 2; ++a)
#pragma unroll
            for (int b = 0; b < 2; ++b)
#pragma unroll
                for (int m = 0; m < 4; ++m)
#pragma unroll
                    for (int n = 0; n < 2; ++n) acc[a][b][m][n] = (f32x4){0.f, 0.f, 0.f, 0.f};
        cur = nxt; cA = nA; cB = nB; ++ui;
        if constexpr (ALIGN_EPI) { if (wr == 1) PG8_BAR; }
    }
    PG8_WAIT_V(0);
    if constexpr (!ALIGN_EPI) { if (wr == 0) PG8_BAR; }
    PG8_BAR;
    if constexpr (Epi::AFTER_DRAIN) { E.fused(acc, cur, wr, wc, fr, fq, lds, wid, lane); S.done(cur); }
#undef PG8_SA
#undef PG8_SB
#undef PG8_STAGE
#undef PG8_LDA
#undef PG8_LDB
#undef PG8_MMA
#undef PG8_WAIT_V
#undef PG8_WAIT_L
#undef PG8_BAR
#undef PG8_SCHED
}
}
#include <hip/hip_bf16.h>
#include <cmath>
namespace attn_body {
using bf16=__hip_bfloat16;
using bf16x8=__attribute__((ext_vector_type(8)))short;
using s16x4=__attribute__((ext_vector_type(4)))short;
using f32x16=__attribute__((ext_vector_type(16)))float;
using u32x4=__attribute__((ext_vector_type(4)))unsigned;
constexpr int BATCH=2,SEQ=4096,D=64,DM=18432,DMO=4096;
constexpr int NW=8,QBLK=32,QB=QBLK*NW,KVBLK=64,NQB=SEQ/QB;
constexpr int ATTN_PITCH=DM, ATTN_UNIT_ROWS=QB;
__device__ __forceinline__ int crow(int r,int hi){return (r&3)+8*(r>>2)+4*hi;}
#define SBAR() __builtin_amdgcn_sched_barrier(0)
__device__ __forceinline__ void cmask(f32x16&p0,f32x16&p1,int jb,int qrel,int hi){
  const float NEG=-INFINITY; int kb=64*jb+4*hi;
  #pragma unroll
  for(int r=0;r<16;++r){int kv=kb+(r&3)+8*(r>>2); if(kv>qrel)p0[r]=NEG; if(kv+32>qrel)p1[r]=NEG;}
}

constexpr int NSLOT=3, SLOTB=8192;
constexpr int LDS_K=0, LDS_V=NSLOT*SLOTB, LDS_WS=LDS_V+NSLOT*2*SLOTB, LDS_OST=LDS_WS+NW*64*4, LDS_BYTES=LDS_OST+NW*8192;
constexpr float C2=0.125f*1.4426950408889634f;
__device__ __forceinline__ void glds16(const void*gsrc,unsigned lds_dst){unsigned keep;
  asm volatile("s_mov_b32 %0, m0\n\ts_mov_b32 m0, %2\n\ts_nop 0\n\tglobal_load_lds_dwordx4 %1, off\n\ts_mov_b32 m0, %0":"=&s"(keep):"v"(gsrc),"s"(lds_dst):"memory");}
__device__ __forceinline__ float max3f(float a,float b,float c){float r;asm("v_max3_f32 %0, %1, %2, %3":"=v"(r):"v"(a),"v"(b),"v"(c));return r;}
__device__ __forceinline__ float max2f(float a,float b){float r;asm("v_max_f32_e32 %0, %1, %2":"=v"(r):"v"(a),"v"(b));return r;}
__device__ __forceinline__ float fadd_s(float a,float b){float r;asm("v_add_f32_e32 %0, %1, %2":"=v"(r):"v"(a),"v"(b));return r;}
__device__ __forceinline__ float fsub_s(float a,float b){float r;asm("v_sub_f32_e32 %0, %1, %2":"=v"(r):"v"(a),"v"(b));return r;}
typedef float f32x2_t __attribute__((ext_vector_type(2))); typedef __bf16 bf16x2_t __attribute__((ext_vector_type(2)));
__device__ __forceinline__ unsigned cvtpk_s(float lo,float hi){f32x2_t v={lo,hi};bf16x2_t b=__builtin_convertvector(v,bf16x2_t);return __builtin_bit_cast(unsigned,b);}
#define WAIT_BAR(N) asm volatile("s_waitcnt vmcnt(" #N ") lgkmcnt(0)\n\ts_barrier":::"memory")

__device__ __forceinline__ void qkt(f32x16&p0,f32x16&p1,const char*Kslot,const bf16x8*qr,const f32x16&negm,int r32,int hi){
  const char*kb=Kslot+hi*1024+r32*16;
  #pragma unroll
  for(int d0=0;d0<4;++d0){
    const bf16x8 b0=*reinterpret_cast<const bf16x8*>(kb+d0*2048);
    const bf16x8 b1=*reinterpret_cast<const bf16x8*>(kb+d0*2048+512);
    if(d0==0){p0=__builtin_amdgcn_mfma_f32_32x32x16_bf16(b0,qr[0],negm,0,0,0);p1=__builtin_amdgcn_mfma_f32_32x32x16_bf16(b1,qr[0],negm,0,0,0);}
    else{p0=__builtin_amdgcn_mfma_f32_32x32x16_bf16(b0,qr[d0],p0,0,0,0);p1=__builtin_amdgcn_mfma_f32_32x32x16_bf16(b1,qr[d0],p1,0,0,0);}}
}
typedef __attribute__((address_space(3))) const char* lds_cptr;
typedef short v4i16_t __attribute__((ext_vector_type(4)));
__device__ __forceinline__ void kload8(bf16x8*kf,lds_cptr kp){
  kf[0]=*(const __attribute__((address_space(3))) bf16x8*)(kp);      kf[1]=*(const __attribute__((address_space(3))) bf16x8*)(kp+512);
  kf[2]=*(const __attribute__((address_space(3))) bf16x8*)(kp+2048); kf[3]=*(const __attribute__((address_space(3))) bf16x8*)(kp+2560);
  kf[4]=*(const __attribute__((address_space(3))) bf16x8*)(kp+4096); kf[5]=*(const __attribute__((address_space(3))) bf16x8*)(kp+4608);
  kf[6]=*(const __attribute__((address_space(3))) bf16x8*)(kp+6144); kf[7]=*(const __attribute__((address_space(3))) bf16x8*)(kp+6656);
}
__device__ __forceinline__ void kload2(bf16x8*kf,lds_cptr kp,int j){ kf[2*j]=*(const __attribute__((address_space(3))) bf16x8*)(kp+j*2048); kf[2*j+1]=*(const __attribute__((address_space(3))) bf16x8*)(kp+j*2048+512); }
__device__ __forceinline__ s16x4 vtr(lds_cptr p){ return __builtin_bit_cast(s16x4,__builtin_amdgcn_ds_read_tr16_b64_v4i16((__attribute__((address_space(3))) v4i16_t*)p)); }
__device__ __forceinline__ float rowmax(const f32x16&p0,const f32x16&p1){
  float a=max3f(p0[0],p0[1],p1[0]),b=max3f(p0[2],p0[3],p1[1]);a=max3f(a,p1[2],p1[3]);
  #pragma unroll
  for(int r=4;r<16;r+=4){a=max3f(a,p0[r],p0[r+1]);b=max3f(b,p0[r+2],p0[r+3]);a=max3f(a,p1[r],p1[r+1]);b=max3f(b,p1[r+2],p1[r+3]);}
  const float m=max2f(a,b);
  auto rr=__builtin_amdgcn_permlane32_swap(__float_as_uint(m),__float_as_uint(m),false,false);
  return max2f(__uint_as_float(rr[0]),__uint_as_float(rr[1]));
}
__device__ __forceinline__ void pv(f32x16*o,int vb,bf16x8 pa0,bf16x8 pa1,bf16x8 pa2,bf16x8 pa3){
  #pragma unroll
  for(int d0=0;d0<4;++d0){s16x4 lo[4],hi[4];
    #pragma unroll
    for(int ks=0;ks<4;++ks){
      asm volatile("ds_read_b64_tr_b16 %0,%1 offset:%c2":"=&v"(lo[ks]):"v"(vb),"i"(d0*4096+ks*1024):"memory");
      asm volatile("ds_read_b64_tr_b16 %0,%1 offset:%c2":"=&v"(hi[ks]):"v"(vb),"i"(d0*4096+ks*1024+512):"memory");}
    asm volatile("s_waitcnt lgkmcnt(0)":::"memory");SBAR();
    #define PK(k) (bf16x8){lo[k][0],lo[k][1],lo[k][2],lo[k][3],hi[k][0],hi[k][1],hi[k][2],hi[k][3]}
    o[d0]=__builtin_amdgcn_mfma_f32_32x32x16_bf16(pa0,PK(0),o[d0],0,0,0);
    o[d0]=__builtin_amdgcn_mfma_f32_32x32x16_bf16(pa1,PK(1),o[d0],0,0,0);
    o[d0]=__builtin_amdgcn_mfma_f32_32x32x16_bf16(pa2,PK(2),o[d0],0,0,0);
    o[d0]=__builtin_amdgcn_mfma_f32_32x32x16_bf16(pa3,PK(3),o[d0],0,0,0);
    #undef PK
  }
}

#ifndef ATTN_STORE16
#define ATTN_STORE16(p,v) (*(u32x4*)(p)=(v))
#endif
template<int THRL> __device__ __forceinline__ void attn_unit(int b,int qb,const bf16*Q,const bf16*__restrict__ K,const bf16*__restrict__ V,bf16*O,char*shm,const int tid){
  const int lane=tid&63,r32=lane&31,hi=lane>>5; const int wid=__builtin_amdgcn_readfirstlane(tid>>6);
  const long rowbase=(long)b*SEQ; const int q0=qb*QB;
  const bf16*Qw=Q+(rowbase+q0+wid*QBLK)*DM;
  const bf16*Kh=K+rowbase*DM,*Vh=V+rowbase*DM;
  const unsigned lds0=(unsigned)(uintptr_t)shm;
  float*wsf=(float*)(shm+LDS_WS)+wid*64;
  const bf16*ksrc=Kh+(long)lane*DM+wid*8;
  const bf16*vsrc=Vh+(long)(16*(wid&3)+(lane>>2))*DM+(wid>>2)*32+(lane&3)*8;
  const unsigned kdst=lds0+LDS_K+wid*1024, vdst=lds0+LDS_V+wid*1024;
  #define DMA_K(t,slot) glds16(ksrc+(long)(t)*KVBLK*DM,(unsigned)__builtin_amdgcn_readfirstlane(kdst+(slot)))
  #define DMA_V(t,slot) do{ glds16(vsrc+(long)(t)*KVBLK*DM,(unsigned)__builtin_amdgcn_readfirstlane(vdst+2*(slot))); glds16(vsrc+(long)(t)*KVBLK*DM+64,(unsigned)__builtin_amdgcn_readfirstlane(vdst+2*(slot)+8192)); }while(0)
  const int vb0=(int)(lds0+LDS_V)+((lane>>4)&1)*32+(lane&3)*8+(4*hi+((lane&15)>>2))*64;
  const char*Kbase=shm+LDS_K; bf16x8 kf[8];
  const lds_cptr shm3=(lds_cptr)shm; const lds_cptr kp0=shm3+LDS_K+hi*1024+r32*16; const lds_cptr vp0=shm3+LDS_V+((lane>>4)&1)*32+(lane&3)*8+(4*hi+((lane&15)>>2))*64;
  const int NT=(q0+QB)/KVBLK;
  DMA_K(0,0);DMA_V(0,0);DMA_K(1,SLOTB);
  bf16x8 qr[4];
  #pragma unroll
  for(int d0=0;d0<4;++d0)qr[d0]=*reinterpret_cast<const bf16x8*>(&Qw[(long)r32*DM+d0*16+hi*8]);
  float zz_; asm volatile("v_mov_b32 %0, 0":"=v"(zz_)); float mhat=0.f,l_reg=0.f;f32x16 o[4],negm;
  _Pragma("unroll") for(int r=0;r<16;++r){o[0][r]=zz_;o[1][r]=zz_;o[2][r]=zz_;o[3][r]=zz_;negm[r]=zz_;} asm volatile("":"+v"(negm));
  const int qrel=wid*QBLK+r32;
  #define CMASK(P0,P1,t) do{int jb_=(t)-(NT-4); if(jb_>=0){int hi_=hi,qr_=qrel; asm volatile("":"+v"(hi_),"+v"(qr_)); cmask(P0,P1,jb_,qr_,hi_);} }while(0)
  bool resc=false;
  #define START(P0,P1) do{ const float rm=rowmax(P0,P1); resc=false; \
    { const float dl=rm; mhat=fadd_s(mhat,dl); \
      _Pragma("unroll") for(int r=0;r<16;++r){P0[r]=fsub_s(P0[r],dl);P1[r]=fsub_s(P1[r],dl);} \
      _Pragma("unroll") for(int r=0;r<16;++r)negm[r]=-mhat; asm volatile("":"+v"(negm)); } \
    _Pragma("unroll") for(int r=0;r<16;++r)P0[r]=__builtin_amdgcn_exp2f(P0[r]); }while(0)
  #define RESC() do{ if(resc){ asm volatile("s_waitcnt lgkmcnt(0)":::"memory"); \
      _Pragma("unroll") for(int d_=0;d_<4;++d_) _Pragma("unroll") for(int r=0;r<16;++r)o[d_][r]*=wsf[crow(r,hi)]; } }while(0)
  f32x16 pA0,pA1,pB0,pB1;
  int sl_prev=0,sl_cur=0,sl_next=SLOTB;
  #define ROT() do{sl_prev=sl_cur;sl_cur=sl_next;sl_next=(sl_next==(NSLOT-1)*SLOTB)?0:sl_next+SLOTB;}while(0)
  DMA_K(2,2*SLOTB);
  WAIT_BAR(3);
  qkt(pA0,pA1,Kbase,qr,negm,r32,hi);asm volatile("s_nop 15\n\ts_nop 7":"+v"(pA0),"+v"(pA1));CMASK(pA0,pA1,0);
  START(pA0,pA1);
  _Pragma("unroll") for(int r=0;r<16;++r)pA1[r]=__builtin_amdgcn_exp2f(pA1[r]);
  WAIT_BAR(0);
  DMA_K(3,0);DMA_V(1,SLOTB);
  ROT();
  kload8(kf,kp0+sl_cur);
  WAIT_BAR(3);
  s16x4 vl[4],vh[4]; u32x4 pw0,pw1,pw2,pw3;
  #define PKW(P,B) cvtpk_s(P[B],P[B+1])
  #define PAF(k) __builtin_bit_cast(bf16x8,pw##k)
  #define VFS(g) (bf16x8){vl[(g)&3][0],vl[(g)&3][1],vl[(g)&3][2],vl[(g)&3][3],vh[(g)&3][0],vh[(g)&3][1],vh[(g)&3][2],vh[(g)&3][3]}
  #define PIN(x) asm volatile("":"+v"(x))
  #define MX3(a,b,c) __builtin_fmaxf(__builtin_fmaxf((a),(b)),(c))
  #define GAPA(MF,A0,A1,A2,A3,W0,W1,PW) do{ MF; sacc+=A0; sacc+=A1; sacc+=A2; sacc+=A3; PIN(sacc); W0; W1; PIN(PW); SBAR(); }while(0)
  #define EX(v) __builtin_amdgcn_exp2f(v)
  #define GAPB(MF,X,B) do{ MF; X[B]=EX(X[B]); X[B+1]=EX(X[B+1]); PIN(X); SBAR(); }while(0)
  #define VRD(g) do{ vl[(g)&3]=vtr(vp_+(((g)&3)*4096+((g)>>2)*1024)); vh[(g)&3]=vtr(vp_+(((g)&3)*4096+((g)>>2)*1024+512)); SBAR(); }while(0)
  #define KRD(G,j) do{ if(G){ kload2(kf,kp0+sl_next,j); SBAR(); } }while(0)
  #define STEP(C0,C1,P0,P1,t,GK,GV,GL) do{ SBAR(); \
    const lds_cptr vp_=vp0+2*sl_prev; \
    if(GV){DMA_V((t)+1,sl_next);} if(GK){DMA_K((t)+3,sl_cur);}   \
    float sacc=(P0[0]+P0[1]); __builtin_amdgcn_s_setprio(1); \
    GAPA(C0=__builtin_amdgcn_mfma_f32_32x32x16_bf16(kf[0],qr[0],negm,0,0,0), P0[2],P0[3],P0[4],P0[5],     pw0[0]=PKW(P0,0), pw0[1]=PKW(P0,2), pw0); \
    GAPA(C1=__builtin_amdgcn_mfma_f32_32x32x16_bf16(kf[1],qr[0],negm,0,0,0), P0[6],P0[7],P0[8],P0[9],     pw0[2]=PKW(P0,4), pw0[3]=PKW(P0,6), pw0); \
    GAPA(C0=__builtin_amdgcn_mfma_f32_32x32x16_bf16(kf[2],qr[1],C0,0,0,0),   P0[10],P0[11],P0[12],P0[13], pw1[0]=PKW(P0,8), pw1[1]=PKW(P0,10), pw1); \
    GAPA(C1=__builtin_amdgcn_mfma_f32_32x32x16_bf16(kf[3],qr[1],C1,0,0,0),   P0[14],P0[15],P1[0],P1[1],   pw1[2]=PKW(P0,12),pw1[3]=PKW(P0,14), pw1); \
    GAPA(C0=__builtin_amdgcn_mfma_f32_32x32x16_bf16(kf[4],qr[2],C0,0,0,0),   P1[2],P1[3],P1[4],P1[5],     pw2[0]=PKW(P1,0), pw2[1]=PKW(P1,2), pw2); \
    GAPA(C1=__builtin_amdgcn_mfma_f32_32x32x16_bf16(kf[5],qr[2],C1,0,0,0),   P1[6],P1[7],P1[8],P1[9],     pw2[2]=PKW(P1,4), pw2[3]=PKW(P1,6), pw2); \
    GAPA(C0=__builtin_amdgcn_mfma_f32_32x32x16_bf16(kf[6],qr[3],C0,0,0,0),   P1[10],P1[11],P1[12],P1[13], pw3[0]=PKW(P1,8), pw3[1]=PKW(P1,10), pw3); \
    GAPA(C1=__builtin_amdgcn_mfma_f32_32x32x16_bf16(kf[7],qr[3],C1,0,0,0),   P1[14],P1[15],0.f,0.f,       pw3[2]=PKW(P1,12),pw3[3]=PKW(P1,14), pw3); \
    __builtin_amdgcn_s_setprio(0); l_reg+=sacc; \
    VRD(0); VRD(1); VRD(2); \
    CMASK(C0,C1,t); \
    { float a=MX3(C0[0],C0[1],C1[0]),b=MX3(C0[2],C0[3],C1[1]); a=MX3(a,C1[2],C1[3]); \
      _Pragma("unroll") for(int r=4;r<16;r+=4){a=MX3(a,C0[r],C0[r+1]);b=MX3(b,C0[r+2],C0[r+3]);a=MX3(a,C1[r],C1[r+1]);b=MX3(b,C1[r+2],C1[r+3]);} \
      float rm=__builtin_fmaxf(a,b); { auto rr=__builtin_amdgcn_permlane32_swap(__float_as_uint(rm),__float_as_uint(rm),false,false); rm=__builtin_fmaxf(__uint_as_float(rr[0]),__uint_as_float(rr[1])); } \
      resc=false; \
      if(__builtin_expect(__any(rm>(float)THRL),0)){ const float dl=__builtin_fmaxf(rm,0.f); mhat+=dl; \
        _Pragma("unroll") for(int r=0;r<16;++r){C0[r]-=dl;C1[r]-=dl;} \
        _Pragma("unroll") for(int r=0;r<16;++r)negm[r]=-mhat; asm volatile("":"+v"(negm)); \
        const float f=__builtin_amdgcn_exp2f(-dl); l_reg*=f; if(hi==0)wsf[r32]=f; resc=true; } } \
    SBAR(); __builtin_amdgcn_s_setprio(1); \
    VRD(3);  GAPB(o[0]=__builtin_amdgcn_mfma_f32_32x32x16_bf16(PAF(0),VFS(0),o[0],0,0,0), C0,0); \
    VRD(4);  GAPB(o[1]=__builtin_amdgcn_mfma_f32_32x32x16_bf16(PAF(0),VFS(1),o[1],0,0,0), C0,2); \
    VRD(5);  GAPB(o[2]=__builtin_amdgcn_mfma_f32_32x32x16_bf16(PAF(0),VFS(2),o[2],0,0,0), C0,4); \
    VRD(6);  GAPB(o[3]=__builtin_amdgcn_mfma_f32_32x32x16_bf16(PAF(0),VFS(3),o[3],0,0,0), C0,6); \
    KRD(GL,0); VRD(7);  GAPB(o[0]=__builtin_amdgcn_mfma_f32_32x32x16_bf16(PAF(1),VFS(4),o[0],0,0,0), C0,8); \
    VRD(8);  GAPB(o[1]=__builtin_amdgcn_mfma_f32_32x32x16_bf16(PAF(1),VFS(5),o[1],0,0,0), C0,10); \
    KRD(GL,1); VRD(9);  GAPB(o[2]=__builtin_amdgcn_mfma_f32_32x32x16_bf16(PAF(1),VFS(6),o[2],0,0,0), C0,12); \
    VRD(10);  GAPB(o[3]=__builtin_amdgcn_mfma_f32_32x32x16_bf16(PAF(1),VFS(7),o[3],0,0,0), C0,14); \
    KRD(GL,2); VRD(11); GAPB(o[0]=__builtin_amdgcn_mfma_f32_32x32x16_bf16(PAF(2),VFS(8),o[0],0,0,0), C1,0); \
    VRD(12); GAPB(o[1]=__builtin_amdgcn_mfma_f32_32x32x16_bf16(PAF(2),VFS(9),o[1],0,0,0), C1,2); \
    KRD(GL,3); VRD(13); GAPB(o[2]=__builtin_amdgcn_mfma_f32_32x32x16_bf16(PAF(2),VFS(10),o[2],0,0,0), C1,4); \
    VRD(14); GAPB(o[3]=__builtin_amdgcn_mfma_f32_32x32x16_bf16(PAF(2),VFS(11),o[3],0,0,0), C1,6); \
    VRD(15); GAPB(o[0]=__builtin_amdgcn_mfma_f32_32x32x16_bf16(PAF(3),VFS(12),o[0],0,0,0), C1,8); \
    GAPB(o[1]=__builtin_amdgcn_mfma_f32_32x32x16_bf16(PAF(3),VFS(13),o[1],0,0,0), C1,10); \
    GAPB(o[2]=__builtin_amdgcn_mfma_f32_32x32x16_bf16(PAF(3),VFS(14),o[2],0,0,0), C1,12); \
    GAPB(o[3]=__builtin_amdgcn_mfma_f32_32x32x16_bf16(PAF(3),VFS(15),o[3],0,0,0), C1,14); __builtin_amdgcn_s_setprio(0); \
    }while(0)
  int t=1;
  #undef CMASK
  #define CMASK(P0,P1,t) do{}while(0)
  for(;t+5<NT;t+=2){
    STEP(pB0,pB1,pA0,pA1,t,true,true,true);     WAIT_BAR(3); RESC(); ROT();
    STEP(pA0,pA1,pB0,pB1,t+1,true,true,true);   WAIT_BAR(3); RESC(); ROT();
  }
  #undef CMASK
  #define CMASK(P0,P1,t) do{int jb_=(t)-(NT-4); if(jb_>=0){int hi_=hi,qr_=qrel; asm volatile("":"+v"(hi_),"+v"(qr_)); cmask(P0,P1,jb_,qr_,hi_);} }while(0)
  #define ENDW(tt) do{ if((tt)+3<NT){WAIT_BAR(3);} else if((tt)+2<NT){WAIT_BAR(2);} else {WAIT_BAR(0);} }while(0)
  for(;t+1<NT;t+=2){
    STEP(pB0,pB1,pA0,pA1,t,(t+3<NT),(t+1<NT),(t+1<NT));       ENDW(t);   RESC(); ROT();
    STEP(pA0,pA1,pB0,pB1,t+1,(t+4<NT),(t+2<NT),(t+2<NT));     ENDW(t+1); RESC(); ROT();
  }
  STEP(pB0,pB1,pA0,pA1,NT-1,false,false,false); RESC();
  { float sacc=pB0[0]+pB0[1]; _Pragma("unroll") for(int r=2;r<16;++r)sacc+=pB0[r]; _Pragma("unroll") for(int r=0;r<16;++r)sacc+=pB1[r]; l_reg+=sacc;
    pw0=(u32x4){PKW(pB0,0),PKW(pB0,2),PKW(pB0,4),PKW(pB0,6)};pw1=(u32x4){PKW(pB0,8),PKW(pB0,10),PKW(pB0,12),PKW(pB0,14)};pw2=(u32x4){PKW(pB1,0),PKW(pB1,2),PKW(pB1,4),PKW(pB1,6)};pw3=(u32x4){PKW(pB1,8),PKW(pB1,10),PKW(pB1,12),PKW(pB1,14)};
    SBAR(); pv(o,vb0+2*sl_cur,PAF(0),PAF(1),PAF(2),PAF(3)); }
  #undef PKW
  #undef PAF
  #undef VFS
  #undef PIN
  #undef MX3
  #undef GAPA
  #undef GAPB
  #undef EX
  #undef VRD
  #undef KRD
  #undef STEP
  #undef ENDW
  int lane_e; asm volatile("v_mbcnt_lo_u32_b32 %0, -1, 0\n\tv_mbcnt_hi_u32_b32 %0, -1, %0":"=v"(lane_e)); const int r32e=lane_e&31,hie=lane_e>>5;
  {auto rr=__builtin_amdgcn_permlane32_swap(__float_as_uint(l_reg),__float_as_uint(l_reg),false,false);l_reg=__uint_as_float(rr[0])+__uint_as_float(rr[1]);}
  float*wsfe=(float*)(shm+LDS_WS)+wid*64;
  if(hie==0)wsfe[32+r32e]=l_reg;asm volatile("s_waitcnt lgkmcnt(0)":::"memory");
  float rli[16];
  #pragma unroll
  for(int r=0;r<16;++r)rli[r]=__builtin_amdgcn_rcpf(wsfe[32+crow(r,hie)]);
  bf16*Ow=O+((long)b*SEQ+qb*QB+wid*QBLK)*DMO;
  { bf16*stg=(bf16*)(shm+LDS_OST)+wid*4096;
    #pragma unroll
    for(int r=0;r<16;++r){const int orow=crow(r,hie);
      #pragma unroll
      for(int d0=0;d0<4;++d0)stg[orow*128+d0*32+r32e]=__float2bfloat16(o[d0][r]*rli[r]);}
    asm volatile("s_waitcnt lgkmcnt(0)":::"memory");
    #pragma unroll
    for(int i=0;i<8;++i){const int row=i*4+(lane_e>>4),ch=lane_e&15; const u32x4 v=*(const u32x4*)(stg+row*128+ch*8); ATTN_STORE16(Ow+(long)row*DMO+ch*8,v);} }
  asm volatile("s_waitcnt lgkmcnt(0)\n\ts_barrier":::"memory");
  #undef DMA_K
  #undef DMA_V
  #undef CMASK
  #undef START
  #undef RESC
  #undef ROT
}
constexpr int ATTN_LDS_BYTES=LDS_BYTES;
#undef SBAR
#undef WAIT_BAR
}
namespace cg = cooperative_groups;
#define LAS __attribute__((address_space(3)))
typedef unsigned short bf16;
typedef unsigned v4u __attribute__((ext_vector_type(4)));
typedef unsigned v2u __attribute__((ext_vector_type(2)));
typedef float f32x4 __attribute__((ext_vector_type(4)));
typedef short bf16x8 __attribute__((ext_vector_type(8)));

constexpr int NWAVES = 8, NTHR = 512;
constexpr int TOK = 8192, SEQL = 4096, DMOD = 2048, NIN = 18448, NPP = 18432, DEPTH = 4;
constexpr int C_AQ = 0, C_AK = 1024, C_AV = 2048, C_AG = 4096, C_BQ = 6144, C_BK = 8192, C_BV = 10240, C_BG = 12288, C_MA = 14336, C_MB = 16384;
constexpr float EPSN = 1e-6f;
constexpr size_t MiB = 1u << 20;
constexpr size_t WS_WLR = 1 * MiB;
constexpr size_t WS_WIN = 2 * MiB;
constexpr size_t WS_WABO = 290 * MiB;
constexpr size_t WS_H = 386 * MiB;
constexpr size_t WS_P = 418 * MiB;
constexpr size_t WS_ALR = 706 * MiB;
constexpr size_t WS_QG = 707 * MiB;
constexpr size_t WS_KHT = 723 * MiB;
constexpr size_t WS_VTG = 739 * MiB;
constexpr size_t WS_DG = 771 * MiB;
constexpr size_t WS_OG = 772 * MiB;
constexpr size_t WS_OB = 836 * MiB;
constexpr size_t WS_OA = 900 * MiB;
constexpr size_t WS_OBF = 932 * MiB;
constexpr size_t WS_T1 = 964 * MiB;
constexpr size_t WS_MG = 1028 * MiB;
constexpr size_t WS_OUT = 1060 * MiB;
constexpr size_t WS_PS = 1124 * MiB;
constexpr size_t WS_END = 1125 * MiB;
constexpr int LDS_BYTES = 147456;
constexpr int MISC_OFF = 147456 - 256;
constexpr int CW_BAR = 4096;
constexpr size_t CTL_ZERO_BYTES = 1 * MiB;
constexpr int CW_XCNT = 16384;
constexpr int CW_QUEUE = 8192;

#define LDS_WAIT() asm volatile("s_waitcnt lgkmcnt(0)" ::: "memory")
__device__ __forceinline__ unsigned f2bf(float f) { unsigned u = __builtin_bit_cast(unsigned, f); return (u + 0x7fffu + ((u >> 16) & 1u)) >> 16; }
typedef float f32x2_t_ __attribute__((ext_vector_type(2))); typedef __bf16 bf16x2_t_ __attribute__((ext_vector_type(2)));
__device__ __forceinline__ unsigned pk2(float lo, float hi) { f32x2_t_ v = {lo, hi}; bf16x2_t_ b = __builtin_convertvector(v, bf16x2_t_); return __builtin_bit_cast(unsigned, b); }
__device__ __forceinline__ float bf2f(unsigned short b) { return __uint_as_float(((unsigned)b) << 16); }
__device__ __forceinline__ float blo(unsigned w) { return __uint_as_float(w << 16); }
__device__ __forceinline__ float bhi(unsigned w) { return __uint_as_float(w & 0xffff0000u); }
__device__ __forceinline__ float shx(float v, int m, int lane) { return __uint_as_float(__builtin_amdgcn_ds_bpermute(((lane ^ m) & 63) << 2, __float_as_uint(v))); }
__device__ __forceinline__ float wave_sum(float v, int lane) {
#pragma unroll
    for (int o = 1; o < 64; o <<= 1) v += shx(v, o, lane);
    return v;
}
__device__ __forceinline__ float fexp(float x) { return __builtin_amdgcn_exp2f(1.4426950408889634f * x); }
__device__ __forceinline__ float siluf(float x) { return x * __builtin_amdgcn_rcpf(1.0f + fexp(-x)); }

#define XB_TMO      128
#define XB_XCNT(j)  (256  + 64 * (j))
#define XB_XSUB(j)  (1280 + 64 * (j))
#define XB_XGEN(j)  (2304 + 64 * (j))
#define XB_TOP      3328
#define XB_TOPGEN   3392
#define XCD_BAR_WORDS 3456
#define XB_SPIN_CAP (1u << 18)

__device__ __forceinline__ unsigned xb_ld(unsigned* p)              { return __hip_atomic_load(p, __ATOMIC_RELAXED, __HIP_MEMORY_SCOPE_AGENT); }
__device__ __forceinline__ unsigned xb_add(unsigned* p, unsigned v) { return __hip_atomic_fetch_add(p, v, __ATOMIC_RELAXED, __HIP_MEMORY_SCOPE_AGENT); }
__device__ __forceinline__ unsigned xb_xcc_id() { return (unsigned)__builtin_amdgcn_s_getreg((3 << 11) | 20) & 0xFu; }
#define XB_SPIN(cond, bar) do { unsigned _sp = 0; while (cond) { __builtin_amdgcn_s_sleep(1); \
    if ((++_sp & 255u) == 0u) { if (xb_ld(&(bar)[XB_TMO])) break; if (_sp > XB_SPIN_CAP) { atomicAdd(&(bar)[XB_TMO], 1u); break; } } } } while (0)

struct XcdBarrier {
    unsigned* bar; unsigned x;
    volatile LAS unsigned* st;
};

__device__ __forceinline__ XcdBarrier xcd_barrier_post(unsigned* bar, volatile LAS unsigned* st, int tid) {
    XcdBarrier b; b.bar = bar; b.x = xb_xcc_id(); b.st = st;
    if (tid == 0) (void)xb_add(&bar[XB_XCNT(b.x)], 1u);
    return b;
}
__device__ __forceinline__ void xcd_barrier_complete(unsigned* bar, unsigned x, unsigned& nloc, unsigned& nx) {
    const unsigned G = gridDim.x * gridDim.y * gridDim.z;
    unsigned sum, cnt, mine, sp = 0u;
    for (;;) {
        sum = 0u; cnt = 0u; mine = 0u;
#pragma unroll
        for (unsigned j = 0; j < 16; ++j) { const unsigned c = xb_ld(&bar[XB_XCNT(j)]); sum += c; cnt += (c > 0u) ? 1u : 0u; mine = (j == x) ? c : mine; }
        if (sum == G) break;
        __builtin_amdgcn_s_sleep(1);
        if ((++sp & 255u) == 0u) { if (xb_ld(&bar[XB_TMO])) break; if (sp > XB_SPIN_CAP) { atomicAdd(&bar[XB_TMO], 1u); break; } }
    }
    nloc = mine > 0u ? mine : 1u; nx = cnt > 0u ? cnt : 1u;
}

__device__ __forceinline__ void xcd_barrier(const XcdBarrier& b, int tid) {
    asm volatile("s_waitcnt vmcnt(0)" ::: "memory");
    __syncthreads();
    if (tid == 0) {
        unsigned* bar = b.bar;
        __builtin_amdgcn_s_waitcnt(0);
        unsigned nloc = b.st[0], nx = b.st[1];
        if (nloc == 0u) { xcd_barrier_complete(bar, b.x, nloc, nx); b.st[0] = nloc; b.st[1] = nx; }
        const unsigned old = xb_add(&bar[XB_XSUB(b.x)], 1u);
        const unsigned gen = old / nloc;
        if (old + 1u == (gen + 1u) * nloc) {
            __builtin_amdgcn_fence(__ATOMIC_RELEASE, "agent");
            asm volatile("s_waitcnt vmcnt(0)" ::: "memory");
            const unsigned og = xb_add(&bar[XB_TOP], 1u);
            const unsigned tg = og / nx;
            if (og + 1u == (tg + 1u) * nx) xb_add(&bar[XB_TOPGEN], 1u);
            else XB_SPIN(xb_ld(&bar[XB_TOPGEN]) == tg, bar);
            __builtin_amdgcn_fence(__ATOMIC_ACQUIRE, "agent");
            xb_add(&bar[XB_XGEN(b.x)], 1u);
            asm volatile("s_waitcnt vmcnt(0)" ::: "memory");
        } else {
            XB_SPIN(xb_ld(&bar[XB_XGEN(b.x)]) == gen, bar);
            __builtin_amdgcn_fence(__ATOMIC_ACQUIRE, "agent");
            asm volatile("s_waitcnt vmcnt(0)" ::: "memory");
        }
    }
    __syncthreads();
}

__device__ __forceinline__ void transpose_item(const float* W, int ldw, int K, int N, bf16* WT, LAS float* scr, int item, int lane) {
    const int nblk = N / 32, kb = item / nblk, nb = item % nblk, k0 = 64 * kb, n0 = 32 * nb;
    const int kr = lane >> 3, c4 = lane & 7;
    f32x4 r[8];
#pragma unroll
    for (int i = 0; i < 8; ++i) r[i] = *(const f32x4*)(W + (size_t)(k0 + 8 * i + kr) * ldw + n0 + 4 * c4);
#pragma unroll
    for (int i = 0; i < 8; ++i) { LAS float* d = scr + (8 * i + kr) * 33 + 4 * c4; d[0] = r[i].x; d[1] = r[i].y; d[2] = r[i].z; d[3] = r[i].w; }
    LDS_WAIT(); asm volatile("" ::: "memory");
    const int c = lane & 7;
#pragma unroll
    for (int j = 0; j < 4; ++j) { const int n = (lane >> 3) + 8 * j; const LAS float* s = scr + (8 * c) * 33 + n;
        v4u o; o.x = pk2(s[0 * 33], s[1 * 33]); o.y = pk2(s[2 * 33], s[3 * 33]); o.z = pk2(s[4 * 33], s[5 * 33]); o.w = pk2(s[6 * 33], s[7 * 33]);
        *(v4u*)(WT + (size_t)(n0 + n) * K + k0 + 8 * c) = o; }
    LDS_WAIT(); asm volatile("" ::: "memory");
}

struct Args { const float* in[12]; float* out; unsigned char* ws; int ph_lo, ph_hi; };
typedef const Args __attribute__((address_space(4))) CArgs;

constexpr int CV_I1 = 32 * (6144 / 32), CV_I2 = 32 * (12288 / 32), CV_I3 = 32 * (2048 / 32), CV_PER = CV_I1 + CV_I2 + 3 * CV_I3;
constexpr int CV_UNITS = CV_PER / 256;
__device__ __forceinline__ void convert_item(CArgs& a, int l, int r, LAS float* scr, int lane) {
    const float* win = a.in[3] + (size_t)l * DMOD * NIN;
    bf16* wt = (bf16*)(a.ws + WS_WIN) + (size_t)l * NPP * DMOD;
    bf16* wabo = (bf16*)(a.ws + WS_WABO) + (size_t)l * 3 * DMOD * DMOD;
    if (r < CV_I1) { transpose_item(win, NIN, DMOD, 6144, wt, scr, r, lane); return; } r -= CV_I1;
    if (r < CV_I2) { transpose_item(win + 6160, NIN, DMOD, 12288, wt + (size_t)6144 * DMOD, scr, r, lane); return; } r -= CV_I2;
    if (r < CV_I3) { transpose_item(a.in[9] + (size_t)l * DMOD * DMOD, DMOD, 2 * DMOD, DMOD, wabo, scr, r, lane); return; } r -= CV_I3;
    if (r < CV_I3) { transpose_item(a.in[10] + (size_t)l * DMOD * DMOD, DMOD, 2 * DMOD, DMOD, wabo + DMOD, scr, r, lane); return; } r -= CV_I3;
    transpose_item(a.in[11] + (size_t)l * DMOD * DMOD, DMOD, DMOD, DMOD, wabo + (size_t)2 * DMOD * DMOD, scr, r, lane);
}
struct CvItem { const float* W; bf16* WT; int ldw, K, k0, n0; };
__device__ __forceinline__ CvItem cv_decode(CArgs& a, int l, int r) {
    const float* win = a.in[3] + (size_t)l * DMOD * NIN;
    bf16* wt = (bf16*)(a.ws + WS_WIN) + (size_t)l * NPP * DMOD;
    bf16* wabo = (bf16*)(a.ws + WS_WABO) + (size_t)l * 3 * DMOD * DMOD;
    CvItem c; int N;
    if (r < CV_I1) { c.W = win; c.ldw = NIN; c.K = DMOD; N = 6144; c.WT = wt; }
    else if ((r -= CV_I1) < CV_I2) { c.W = win + 6160; c.ldw = NIN; c.K = DMOD; N = 12288; c.WT = wt + (size_t)6144 * DMOD; }
    else if ((r -= CV_I2) < CV_I3) { c.W = a.in[9] + (size_t)l * DMOD * DMOD; c.ldw = DMOD; c.K = 2 * DMOD; N = DMOD; c.WT = wabo; }
    else if ((r -= CV_I3) < CV_I3) { c.W = a.in[10] + (size_t)l * DMOD * DMOD; c.ldw = DMOD; c.K = 2 * DMOD; N = DMOD; c.WT = wabo + DMOD; }
    else { r -= CV_I3; c.W = a.in[11] + (size_t)l * DMOD * DMOD; c.ldw = DMOD; c.K = DMOD; N = DMOD; c.WT = wabo + (size_t)2 * DMOD * DMOD; }
    const int nblk = N / 32; c.k0 = 64 * (r / nblk); c.n0 = 32 * (r % nblk);
    return c;
}
__device__ __forceinline__ void cv_load(const CvItem& c, f32x4 (&r)[8], int lane) {
    const int kr = lane >> 3, c4 = lane & 7;
#pragma unroll
    for (int i = 0; i < 8; ++i) r[i] = *(const f32x4*)(c.W + (size_t)(c.k0 + 8 * i + kr) * c.ldw + c.n0 + 4 * c4);
}
__device__ __forceinline__ void cv_store(const CvItem& c, const f32x4 (&r)[8], LAS float* scr, int lane) {
    const int kr = lane >> 3, c4 = lane & 7;
#pragma unroll
    for (int i = 0; i < 8; ++i) { LAS float* d = scr + (8 * i + kr) * 33 + 4 * c4; d[0] = r[i].x; d[1] = r[i].y; d[2] = r[i].z; d[3] = r[i].w; }
    LDS_WAIT(); asm volatile("" ::: "memory");
    const int cc = lane & 7;
#pragma unroll
    for (int j = 0; j < 4; ++j) { const int n = (lane >> 3) + 8 * j; const LAS float* s = scr + (8 * cc) * 33 + n;
        v4u o; o.x = pk2(s[0 * 33], s[1 * 33]); o.y = pk2(s[2 * 33], s[3 * 33]); o.z = pk2(s[4 * 33], s[5 * 33]); o.w = pk2(s[6 * 33], s[7 * 33]);
        *(v4u*)(c.WT + (size_t)(c.n0 + n) * c.K + c.k0 + 8 * cc) = o; }
    LDS_WAIT(); asm volatile("" ::: "memory");
}
__device__ __forceinline__ void convert_wlr_item(CArgs& a, int l, int it, int lane) {
    const int k = it * 64 + lane;
    const f32x4* wp = (const f32x4*)(a.in[3] + (size_t)l * DMOD * NIN + (size_t)k * NIN + 6144);
    bf16* o = (bf16*)(a.ws + WS_WLR) + (size_t)l * 16 * DMOD + k;
#pragma unroll
    for (int c = 0; c < 4; ++c) { const f32x4 w = wp[c];
        o[(size_t)(4 * c + 0) * DMOD] = (bf16)f2bf(w.x); o[(size_t)(4 * c + 1) * DMOD] = (bf16)f2bf(w.y); o[(size_t)(4 * c + 2) * DMOD] = (bf16)f2bf(w.z); o[(size_t)(4 * c + 3) * DMOD] = (bf16)f2bf(w.w); }
}
__device__ __forceinline__ void convert_unit(CArgs& a, LAS unsigned char* lds, int l, int c, int wave, int lane) {
    LAS float* scr = (LAS float*)(lds + wave * 16384);
    if (c == 0) for (int i = 0; i < 4; ++i) convert_wlr_item(a, l, wave + 8 * i, lane);
    f32x4 ra[8], rb[8];
    CvItem ca = cv_decode(a, l, c * 256 + wave), cb;
    cv_load(ca, ra, lane);
#pragma unroll 1
    for (int i = 0; i < 32; i += 2) {
        cb = cv_decode(a, l, c * 256 + wave + 8 * (i + 1)); cv_load(cb, rb, lane);
        cv_store(ca, ra, scr, lane);
        if (i + 2 < 32) { ca = cv_decode(a, l, c * 256 + wave + 8 * (i + 2)); cv_load(ca, ra, lane); }
        cv_store(cb, rb, scr, lane);
    }
}
__device__ __forceinline__ void phase_weights(CArgs& a, LAS unsigned char* lds, int gw, int NGW, int wave, int lane) {
    LAS float* scr = (LAS float*)(lds + wave * 16384);
    if (gw < 32) convert_wlr_item(a, 0, gw, lane);
    for (int it = gw; it < CV_PER; it += NGW) convert_item(a, 0, it, scr, lane);
}

__device__ __forceinline__ void phase_norm(CArgs& a, LAS unsigned char* lds, int l, int gw, int NGW, int wave, int lane) {
    const float* xprev = (l <= 1) ? a.in[0] : a.out;
    const bf16* OUT = (const bf16*)(a.ws + WS_OUT); const float* PS = (const float*)(a.ws + WS_PS);
    bf16* H = (bf16*)(a.ws + WS_H); float* ALR = (float*)(a.ws + WS_ALR);
    LAS unsigned char* hrow = lds + wave * 16384;
    const int fr = lane & 15, fq = lane >> 4;
    for (int row0 = gw; row0 < TOK; row0 += 4 * NGW) {
#pragma unroll 1
        for (int rp = 0; rp < 2; ++rp) {
            f32x4 v[2][8]; v2u ov[2][8]; float ps[2];
#pragma unroll
            for (int q = 0; q < 2; ++q) { const int row = row0 + (2 * rp + q) * NGW;
                const f32x4* xr = (const f32x4*)(xprev + (size_t)row * DMOD) + lane;
#pragma unroll
                for (int j = 0; j < 8; ++j) v[q][j] = xr[64 * j];
                if (l > 0) { const v2u* orow = (const v2u*)(OUT + (size_t)row * DMOD) + lane;
#pragma unroll
                    for (int j = 0; j < 8; ++j) ov[q][j] = orow[64 * j];
                    ps[q] = (lane < 32) ? PS[(size_t)row * 32 + lane] : 0.f; } }
#pragma unroll
            for (int q = 0; q < 2; ++q) { const int row = row0 + (2 * rp + q) * NGW; const int ri = 2 * rp + q;
                if (l > 0) {
                    const f32x4* gp = (const f32x4*)(a.in[2] + (size_t)(l - 1) * DMOD) + lane;
                    const float rs = 1.0f / sqrtf(wave_sum(ps[q], lane) * (1.0f / DMOD) + EPSN);
                    f32x4* xo = (f32x4*)(a.out + (size_t)row * DMOD) + lane;
#pragma unroll
                    for (int j = 0; j < 8; ++j) { const v2u ow_ = ov[q][j]; v[q][j] = v[q][j] + (f32x4){blo(ow_.x), bhi(ow_.x), blo(ow_.y), bhi(ow_.y)} * rs * gp[64 * j]; xo[64 * j] = v[q][j]; }
                }
                if (l == DEPTH) continue;
                float s = 0.f;
#pragma unroll
                for (int j = 0; j < 8; ++j) s += (v[q][j].x * v[q][j].x + v[q][j].y * v[q][j].y) + (v[q][j].z * v[q][j].z + v[q][j].w * v[q][j].w);
                const float rs2 = 1.0f / sqrtf(wave_sum(s, lane) * (1.0f / DMOD) + EPSN);
                const f32x4* gq = (const f32x4*)(a.in[1] + (size_t)l * DMOD) + lane;
                unsigned long long* o8 = (unsigned long long*)(H + (size_t)row * DMOD) + lane;
#pragma unroll
                for (int j = 0; j < 8; ++j) {
                    const f32x4 hv = v[q][j] * rs2 * gq[64 * j];
                    const unsigned long long w = (unsigned long long)pk2(hv.x, hv.y) | ((unsigned long long)pk2(hv.z, hv.w) << 32);
                    o8[64 * j] = w;
                    *(LAS unsigned long long*)(hrow + ri * 4096 + (256 * j + 4 * lane) * 2) = w;
                }
            }
        }
        if (l == DEPTH) continue;
        LDS_WAIT(); asm volatile("" ::: "memory");
        const bf16* wlr = (const bf16*)(a.ws + WS_WLR) + (size_t)l * 16 * DMOD + (size_t)fr * DMOD + 8 * fq;
        f32x4 acc = (f32x4){0.f, 0.f, 0.f, 0.f};
#pragma unroll 1
        for (int kb = 0; kb < 64; kb += 16) {
            bf16x8 Xb[16];
#pragma unroll
            for (int i = 0; i < 16; ++i) Xb[i] = *(const bf16x8*)(wlr + (kb + i) * 32);
#pragma unroll
            for (int i = 0; i < 16; ++i) {
                bf16x8 Y = (bf16x8){0, 0, 0, 0, 0, 0, 0, 0};
                if (fr < 4) Y = *(const LAS bf16x8*)(hrow + fr * 4096 + ((kb + i) * 32 + 8 * fq) * 2);
                acc = __builtin_amdgcn_mfma_f32_16x16x32_bf16(Xb[i], Y, acc, 0, 0, 0);
            }
        }
        if (fr < 4) { const int row = row0 + fr * NGW; if (row < TOK) *(f32x4*)(ALR + (size_t)row * 16 + 4 * fq) = acc; }
        LDS_WAIT(); asm volatile("" ::: "memory");
    }
}

__device__ __forceinline__ void alr_from_h(CArgs& a, LAS unsigned char* lds, int l, int gw, int NGW, int wave, int lane) {
    const bf16* H = (const bf16*)(a.ws + WS_H); float* ALR = (float*)(a.ws + WS_ALR);
    LAS unsigned char* hrow = lds + wave * 16384;
    const int fr = lane & 15, fq = lane >> 4;
    for (int row0 = gw; row0 < TOK; row0 += 4 * NGW) {
        v4u hr[4][4];
#pragma unroll
        for (int ri = 0; ri < 4; ++ri)
#pragma unroll
            for (int j = 0; j < 4; ++j) hr[ri][j] = *(const v4u*)(H + (size_t)(row0 + ri * NGW) * DMOD + (j * 64 + lane) * 8);
#pragma unroll
        for (int ri = 0; ri < 4; ++ri)
#pragma unroll
            for (int j = 0; j < 4; ++j) *(LAS v4u*)(hrow + ri * 4096 + (j * 64 + lane) * 16) = hr[ri][j];
        LDS_WAIT(); asm volatile("" ::: "memory");
        const bf16* wlr = (const bf16*)(a.ws + WS_WLR) + (size_t)l * 16 * DMOD + (size_t)fr * DMOD + 8 * fq;
        f32x4 acc = (f32x4){0.f, 0.f, 0.f, 0.f};
#pragma unroll 1
        for (int kb = 0; kb < 64; kb += 16) {
            bf16x8 Xb[16];
#pragma unroll
            for (int i = 0; i < 16; ++i) Xb[i] = *(const bf16x8*)(wlr + (kb + i) * 32);
#pragma unroll
            for (int i = 0; i < 16; ++i) {
                bf16x8 Y = (bf16x8){0, 0, 0, 0, 0, 0, 0, 0};
                if (fr < 4) Y = *(const LAS bf16x8*)(hrow + fr * 4096 + ((kb + i) * 32 + 8 * fq) * 2);
                acc = __builtin_amdgcn_mfma_f32_16x16x32_bf16(Xb[i], Y, acc, 0, 0, 0);
            }
        }
        if (fr < 4) *(f32x4*)(ALR + (size_t)(row0 + fr * NGW) * 16 + 4 * fq) = acc;
        LDS_WAIT(); asm volatile("" ::: "memory");
    }
}

constexpr int QPB = 528;
constexpr int TPB = 144;
__device__ __forceinline__ bf16x8 ldfrag(const LAS unsigned char* p) { return *(const LAS bf16x8*)p; }

__device__ __forceinline__ void load_v_half_regs(v4u (&r)[4], const bf16* P, int token0, int h, int vh, int tid) {
#pragma unroll
    for (int j = 0; j < 4; ++j) { const int c = tid + j * NTHR, chi = c >> 6, ln = c & 63; const int s = (chi & 3) * 16 + (ln & 15), ch = (chi >> 2) * 4 + (ln >> 4);
        r[j] = *(const v4u*)(P + (size_t)(token0 + s) * NPP + C_AV + h * 512 + vh * 256 + ch * 8); }
}
__device__ __forceinline__ void store_v_half(LAS unsigned char* VT, const v4u (&r)[4], int tid) {
#pragma unroll
    for (int j = 0; j < 4; ++j) { const int c = tid + j * NTHR, chi = c >> 6, ln = c & 63; const int s = (chi & 3) * 16 + (ln & 15), ch = (chi >> 2) * 4 + (ln >> 4);
        const v4u v = r[j];
        LAS unsigned short* d = (LAS unsigned short*)(VT + (ch * 8) * TPB + s * 2);
        d[0 * (TPB / 2)] = (unsigned short)(v.x & 0xffffu); d[1 * (TPB / 2)] = (unsigned short)(v.x >> 16);
        d[2 * (TPB / 2)] = (unsigned short)(v.y & 0xffffu); d[3 * (TPB / 2)] = (unsigned short)(v.y >> 16);
        d[4 * (TPB / 2)] = (unsigned short)(v.z & 0xffffu); d[5 * (TPB / 2)] = (unsigned short)(v.z >> 16);
        d[6 * (TPB / 2)] = (unsigned short)(v.w & 0xffffu); d[7 * (TPB / 2)] = (unsigned short)(v.w >> 16); }
}

__device__ __forceinline__ void gla_intra_unit(CArgs& a, int l, LAS unsigned char* lds, int b, int n, int h, const int tid) {
    const int lane = tid & 63, wid = __builtin_amdgcn_readfirstlane(tid >> 6), fr = lane & 15, fq = lane >> 4;
    LAS unsigned char* QT = lds; LAS unsigned char* KT = lds + 33792; LAS unsigned char* AS = lds + 67584; LAS unsigned char* VT = lds + 76800;
    LAS float* BB = (LAS float*)(lds + 76800);
    LAS float* BL = (LAS float*)(lds + 142336);
    LAS float* HT = (LAS float*)(lds + 143360);
    const int token0 = b * SEQL + n * 64; const int unit = (b * 64 + n) * 4 + h;
    const bf16* P = (const bf16*)(a.ws + WS_P);
    bf16* QG = (bf16*)(a.ws + WS_QG); bf16* KHT = (bf16*)(a.ws + WS_KHT) + (size_t)unit * 256 * 64; bf16* VTG = (bf16*)(a.ws + WS_VTG) + (size_t)unit * 512 * 64;
    float* DG = (float*)(a.ws + WS_DG) + (size_t)unit * 256; bf16* OG = (bf16*)(a.ws + WS_OG);
    const float* ALR = (const float*)(a.ws + WS_ALR);
    v4u rq[4], rk[4];
#pragma unroll
    for (int j = 0; j < 4; ++j) { const int idx = tid + j * NTHR; const bf16* p = P + (size_t)(token0 + (idx >> 5)) * NPP + h * 256 + (idx & 31) * 8; rq[j] = *(const v4u*)(p + C_AQ); rk[j] = *(const v4u*)(p + C_AK); }
    v4u rv0[4], rv1[4];
    load_v_half_regs(rv0, P, token0, h, 0, tid); load_v_half_regs(rv1, P, token0, h, 1, tid);
    const int k = tid & 255, th = wid >> 2;
    LAS float* ALS = (LAS float*)(lds + 67584);
    if (tid < 256) *(LAS f32x4*)(ALS + tid * 4) = *(const f32x4*)(ALR + (size_t)token0 * 16 + tid * 4);
    __syncthreads();
    {
        float w2c[16];
#pragma unroll
        for (int r = 0; r < 16; ++r) w2c[r] = a.in[4][((size_t)l * 16 + r) * 1024 + h * 256 + k];
        const float bias = a.in[5][(size_t)l * 1024 + h * 256 + k];
        float cs[32]; float bc = 0.f;
#pragma unroll
        for (int t = 0; t < 32; ++t) {
            const LAS f32x4* al = (const LAS f32x4*)(ALS + (th * 32 + t) * 16);
            const f32x4 a0 = al[0], a1 = al[1], a2 = al[2], a3 = al[3];
            float lg = bias;
            lg += a0.x * w2c[0]; lg += a0.y * w2c[1]; lg += a0.z * w2c[2]; lg += a0.w * w2c[3]; lg += a1.x * w2c[4]; lg += a1.y * w2c[5]; lg += a1.z * w2c[6]; lg += a1.w * w2c[7];
            lg += a2.x * w2c[8]; lg += a2.y * w2c[9]; lg += a2.z * w2c[10]; lg += a2.w * w2c[11]; lg += a3.x * w2c[12]; lg += a3.y * w2c[13]; lg += a3.z * w2c[14]; lg += a3.w * w2c[15];
            const float ls = fminf(lg, 0.f) - __logf(1.0f + fexp(-fabsf(lg)));
            bc += ls * 0.0625f; cs[t] = bc;
        }
        HT[th * 256 + k] = bc;
        __syncthreads();
        const float h0 = HT[k], h1 = HT[256 + k]; const float off = th ? h0 : 0.f;
#pragma unroll
        for (int t = 0; t < 32; ++t) BB[(th * 32 + t) * 256 + k] = cs[t] + off;
        if (th == 0) { BL[k] = h0 + h1; DG[k] = fexp(h0 + h1); }
    }
    __syncthreads();
#pragma unroll
    for (int j = 0; j < 4; ++j) {
        const int idx = tid + j * NTHR, t = idx >> 5, kc = (idx & 31) * 8;
        const f32x4 b0 = *(const LAS f32x4*)(BB + t * 256 + kc), b1 = *(const LAS f32x4*)(BB + t * 256 + kc + 4);
        const float e0 = fexp(b0.x), e1 = fexp(b0.y), e2 = fexp(b0.z), e3 = fexp(b0.w), e4 = fexp(b1.x), e5 = fexp(b1.y), e6 = fexp(b1.z), e7 = fexp(b1.w);
        const float i0 = fexp(-b0.x), i1 = fexp(-b0.y), i2 = fexp(-b0.z), i3 = fexp(-b0.w), i4 = fexp(-b1.x), i5 = fexp(-b1.y), i6 = fexp(-b1.z), i7 = fexp(-b1.w);
        const v4u q = rq[j], kk = rk[j]; v4u qo, ko;
        qo.x = pk2(blo(q.x) * e0, bhi(q.x) * e1); qo.y = pk2(blo(q.y) * e2, bhi(q.y) * e3); qo.z = pk2(blo(q.z) * e4, bhi(q.z) * e5); qo.w = pk2(blo(q.w) * e6, bhi(q.w) * e7);
        ko.x = pk2(blo(kk.x) * i0, bhi(kk.x) * i1); ko.y = pk2(blo(kk.y) * i2, bhi(kk.y) * i3); ko.z = pk2(blo(kk.z) * i4, bhi(kk.z) * i5); ko.w = pk2(blo(kk.w) * i6, bhi(kk.w) * i7);
        *(LAS v4u*)(QT + t * QPB + kc * 2) = qo; *(LAS v4u*)(KT + t * QPB + kc * 2) = ko;
        *(v4u*)(QG + (size_t)(token0 + t) * 1024 + h * 256 + kc) = qo;
    }
    __syncthreads();
    {
        const float el = fexp(BL[k]);
#pragma unroll
        for (int t8 = 0; t8 < 4; ++t8) {
            float kv[8];
#pragma unroll
            for (int i = 0; i < 8; ++i) kv[i] = bf2f(*(const LAS unsigned short*)(KT + (th * 32 + t8 * 8 + i) * QPB + k * 2)) * el;
            v4u o; o.x = pk2(kv[0], kv[1]); o.y = pk2(kv[2], kv[3]); o.z = pk2(kv[4], kv[5]); o.w = pk2(kv[6], kv[7]);
            *(v4u*)(KHT + (size_t)k * 64 + th * 32 + t8 * 8) = o;
        }
    }
#pragma unroll
    for (int tt = 0; tt < 2; ++tt) {
        const int tile = 2 * wid + tt, si = tile >> 2, ti = tile & 3;
        f32x4 acc = (f32x4){0.f, 0.f, 0.f, 0.f};
        if (si <= ti) {
#pragma unroll
            for (int kk = 0; kk < 8; ++kk) {
                const bf16x8 X = ldfrag(KT + (si * 16 + fr) * QPB + (kk * 32 + 8 * fq) * 2);
                const bf16x8 Y = ldfrag(QT + (ti * 16 + fr) * QPB + (kk * 32 + 8 * fq) * 2);
                acc = __builtin_amdgcn_mfma_f32_16x16x32_bf16(X, Y, acc, 0, 0, 0);
            }
        }
        const int s0 = si * 16 + 4 * fq, t = ti * 16 + fr;
#pragma unroll
        for (int r = 0; r < 4; ++r) if (s0 + r > t) acc[r] = 0.f;
        v2u w; w.x = pk2(acc[0], acc[1]); w.y = pk2(acc[2], acc[3]);
        *(LAS v2u*)(AS + t * TPB + s0 * 2) = w;
    }
#pragma unroll 1
    for (int vh = 0; vh < 2; ++vh) {
        if (vh == 0) store_v_half(VT, rv0, tid); else store_v_half(VT, rv1, tid);
        __syncthreads();
        bf16x8 Yf[4][2];
#pragma unroll
        for (int tt = 0; tt < 4; ++tt)
#pragma unroll
            for (int ks = 0; ks < 2; ++ks) Yf[tt][ks] = ldfrag(AS + (tt * 16 + fr) * TPB + (ks * 32 + 8 * fq) * 2);
#pragma unroll
        for (int v2 = 0; v2 < 2; ++v2) {
            const int vt = 2 * wid + v2;
            const bf16x8 X0 = ldfrag(VT + (vt * 16 + fr) * TPB + (8 * fq) * 2), X1 = ldfrag(VT + (vt * 16 + fr) * TPB + (32 + 8 * fq) * 2);
#pragma unroll
            for (int tt = 0; tt < 4; ++tt) {
                f32x4 acc = (f32x4){0.f, 0.f, 0.f, 0.f};
                acc = __builtin_amdgcn_mfma_f32_16x16x32_bf16(X0, Yf[tt][0], acc, 0, 0, 0);
                acc = __builtin_amdgcn_mfma_f32_16x16x32_bf16(X1, Yf[tt][1], acc, 0, 0, 0);
                { v2u w_; w_.x = pk2(acc[0], acc[1]); w_.y = pk2(acc[2], acc[3]); *(v2u*)(OG + (size_t)(token0 + tt * 16 + fr) * DMOD + h * 512 + vh * 256 + vt * 16 + 4 * fq) = w_; }
            }
        }
#pragma unroll
        for (int j = 0; j < 4; ++j) { const int idx = tid + j * NTHR, vrow = idx >> 3, c8 = idx & 7;
            *(v4u*)(VTG + (size_t)(vh * 256 + vrow) * 64 + c8 * 8) = *(const LAS v4u*)(VT + vrow * TPB + c8 * 16); }
        __syncthreads();
    }
}

__device__ __forceinline__ void gla_inter_unit(CArgs& a, LAS unsigned char* lds, int bh, int vs, const int tid) {
    const int lane = tid & 63, wid = __builtin_amdgcn_readfirstlane(tid >> 6), fr = lane & 15, fq = lane >> 4;
    LAS unsigned char* QT = lds; LAS unsigned char* KH = lds + 33792; LAS unsigned char* VS = lds + 70656; LAS unsigned char* ST = lds + 79872;
    const int b = bh >> 2, h = bh & 3, v0 = vs * 64;
    const bf16* QG = (const bf16*)(a.ws + WS_QG); const bf16* KHT = (const bf16*)(a.ws + WS_KHT); const bf16* VTG = (const bf16*)(a.ws + WS_VTG);
    const float* DG = (const float*)(a.ws + WS_DG); const bf16* OG = (const bf16*)(a.ws + WS_OG);
    f32x4 sacc[2][4];
#pragma unroll
    for (int i = 0; i < 2; ++i)
#pragma unroll
        for (int j = 0; j < 4; ++j) sacc[i][j] = (f32x4){0.f, 0.f, 0.f, 0.f};
    for (int i = tid; i < 33792 / 4; i += NTHR) ((LAS unsigned*)ST)[i] = 0u;
    const int tt = wid >> 1, vp = (wid & 1) * 2;
    v4u rqA[4], rkA[4], rvA, rqB[4], rkB[4], rvB; f32x4 dvA[2], dvB[2]; v2u ogA[2], ogB[2];
#define GI_LOADS_T(n_, S) do { const int token0_ = b * SEQL + (n_) * 64; const size_t unit_ = (size_t)((b * 64 + (n_)) * 4 + h); \
        _Pragma("unroll") for (int j = 0; j < 4; ++j) { const int idx = tid + j * NTHR; rq##S[j] = *(const v4u*)(QG + (size_t)(token0_ + (idx >> 5)) * 1024 + h * 256 + (idx & 31) * 8); } \
        _Pragma("unroll") for (int j = 0; j < 4; ++j) { const int idx = tid + j * NTHR; rk##S[j] = *(const v4u*)(KHT + (unit_ * 256 + (idx >> 3)) * 64 + (idx & 7) * 8); } \
        rv##S = *(const v4u*)(VTG + (unit_ * 512 + v0 + (tid >> 3)) * 64 + (tid & 7) * 8); } while (0)
#define GI_LOADS_D(n_, S) do { const size_t unit_ = (size_t)((b * 64 + (n_)) * 4 + h); \
        _Pragma("unroll") for (int kt = 0; kt < 2; ++kt) dv##S[kt] = *(const f32x4*)(DG + unit_ * 256 + 32 * wid + 16 * kt + 4 * fq); } while (0)
#define GI_LOADS_O(n_, S) do { const int token0_ = b * SEQL + (n_) * 64; \
        _Pragma("unroll") for (int v2 = 0; v2 < 2; ++v2) og##S[v2] = *(const v2u*)(OG + (size_t)(token0_ + tt * 16 + fr) * DMOD + h * 512 + v0 + (vp + v2) * 16 + 4 * fq); } while (0)
#define GI_LOADS(n_, S) do { GI_LOADS_T(n_, S); GI_LOADS_D(n_, S); GI_LOADS_O(n_, S); } while (0)
#define GI_STEP(n_, S) do { const int token0 = b * SEQL + (n_) * 64; \
        _Pragma("unroll") for (int j = 0; j < 4; ++j) { const int idx = tid + j * NTHR; *(LAS v4u*)(QT + (idx >> 5) * QPB + (idx & 31) * 16) = rq##S[j]; } \
        _Pragma("unroll") for (int j = 0; j < 4; ++j) { const int idx = tid + j * NTHR; *(LAS v4u*)(KH + (idx >> 3) * TPB + (idx & 7) * 16) = rk##S[j]; } \
        *(LAS v4u*)(VS + (tid >> 3) * TPB + (tid & 7) * 16) = rv##S; \
        const f32x4 dv0 = dv##S[0], dv1 = dv##S[1]; const v2u g0_ = og##S[0], g1_ = og##S[1]; const f32x4 og0 = (f32x4){blo(g0_.x), bhi(g0_.x), blo(g0_.y), bhi(g0_.y)}, og1 = (f32x4){blo(g1_.x), bhi(g1_.x), blo(g1_.y), bhi(g1_.y)}; \
        __syncthreads(); \
        GI_LOADS_T(((n_) + 2 < 64 ? (n_) + 2 : 63), S);     \
        { f32x4 acc0 = (f32x4){0.f, 0.f, 0.f, 0.f}, acc1 = acc0; bf16x8 Ya_, X0a_, X1a_, Yb_, X0b_, X1b_; \
              \
            _Pragma("unroll") for (int kk = 0; kk < 8; kk += 2) { \
                if (kk == 0) { Ya_ = ldfrag(QT + (tt * 16 + fr) * QPB + (8 * fq) * 2); X0a_ = ldfrag(ST + (vp * 16 + fr) * QPB + (8 * fq) * 2); X1a_ = ldfrag(ST + ((vp + 1) * 16 + fr) * QPB + (8 * fq) * 2); \
                               Yb_ = ldfrag(QT + (tt * 16 + fr) * QPB + (32 + 8 * fq) * 2); X0b_ = ldfrag(ST + (vp * 16 + fr) * QPB + (32 + 8 * fq) * 2); X1b_ = ldfrag(ST + ((vp + 1) * 16 + fr) * QPB + (32 + 8 * fq) * 2); } \
                __builtin_amdgcn_sched_barrier(0); \
                acc0 = __builtin_amdgcn_mfma_f32_16x16x32_bf16(X0a_, Ya_, acc0, 0, 0, 0); acc1 = __builtin_amdgcn_mfma_f32_16x16x32_bf16(X1a_, Ya_, acc1, 0, 0, 0); \
                __builtin_amdgcn_sched_barrier(0); \
                if (kk + 2 < 8) { Ya_ = ldfrag(QT + (tt * 16 + fr) * QPB + ((kk + 2) * 32 + 8 * fq) * 2); X0a_ = ldfrag(ST + (vp * 16 + fr) * QPB + ((kk + 2) * 32 + 8 * fq) * 2); X1a_ = ldfrag(ST + ((vp + 1) * 16 + fr) * QPB + ((kk + 2) * 32 + 8 * fq) * 2); } \
                __builtin_amdgcn_sched_barrier(0); \
                acc0 = __builtin_amdgcn_mfma_f32_16x16x32_bf16(X0b_, Yb_, acc0, 0, 0, 0); acc1 = __builtin_amdgcn_mfma_f32_16x16x32_bf16(X1b_, Yb_, acc1, 0, 0, 0); \
                __builtin_amdgcn_sched_barrier(0); \
                if (kk + 3 < 8) { Yb_ = ldfrag(QT + (tt * 16 + fr) * QPB + ((kk + 3) * 32 + 8 * fq) * 2); X0b_ = ldfrag(ST + (vp * 16 + fr) * QPB + ((kk + 3) * 32 + 8 * fq) * 2); X1b_ = ldfrag(ST + ((vp + 1) * 16 + fr) * QPB + ((kk + 3) * 32 + 8 * fq) * 2); } } \
            bf16* op = (bf16*)(a.ws + WS_T1) + (size_t)(token0 + tt * 16 + fr) * DMOD + h * 512 + v0 + vp * 16 + 4 * fq; \
            const f32x4 s0_ = og0 + acc0, s1_ = og1 + acc1; v2u w0_, w1_; w0_.x = pk2(s0_[0], s0_[1]); w0_.y = pk2(s0_[2], s0_[3]); w1_.x = pk2(s1_[0], s1_[1]); w1_.y = pk2(s1_[2], s1_[3]); \
            *(v2u*)op = w0_; *(v2u*)(op + 16) = w1_; } \
        GI_LOADS_O(((n_) + 2 < 64 ? (n_) + 2 : 63), S); \
        { bf16x8 Xk[2][2], Y0a_, Y1a_, Y0b_, Y1b_; \
            _Pragma("unroll") for (int kt = 0; kt < 2; ++kt) { Xk[kt][0] = ldfrag(KH + (32 * wid + 16 * kt + fr) * TPB + (8 * fq) * 2); Xk[kt][1] = ldfrag(KH + (32 * wid + 16 * kt + fr) * TPB + (32 + 8 * fq) * 2); } \
            Y0a_ = ldfrag(VS + (fr) * TPB + (8 * fq) * 2); Y1a_ = ldfrag(VS + (fr) * TPB + (32 + 8 * fq) * 2); Y0b_ = ldfrag(VS + (16 + fr) * TPB + (8 * fq) * 2); Y1b_ = ldfrag(VS + (16 + fr) * TPB + (32 + 8 * fq) * 2); \
            _Pragma("unroll") for (int v2 = 0; v2 < 4; v2 += 2) { \
                __builtin_amdgcn_sched_barrier(0); \
                _Pragma("unroll") for (int kt = 0; kt < 2; ++kt) { f32x4 s_ = sacc[kt][v2] * (kt ? dv1 : dv0); \
                    s_ = __builtin_amdgcn_mfma_f32_16x16x32_bf16(Xk[kt][0], Y0a_, s_, 0, 0, 0); s_ = __builtin_amdgcn_mfma_f32_16x16x32_bf16(Xk[kt][1], Y1a_, s_, 0, 0, 0); sacc[kt][v2] = s_; } \
                __builtin_amdgcn_sched_barrier(0); \
                if (v2 + 2 < 4) { Y0a_ = ldfrag(VS + ((v2 + 2) * 16 + fr) * TPB + (8 * fq) * 2); Y1a_ = ldfrag(VS + ((v2 + 2) * 16 + fr) * TPB + (32 + 8 * fq) * 2); } \
                __builtin_amdgcn_sched_barrier(0); \
                _Pragma("unroll") for (int kt = 0; kt < 2; ++kt) { f32x4 s_ = sacc[kt][v2 + 1] * (kt ? dv1 : dv0); \
                    s_ = __builtin_amdgcn_mfma_f32_16x16x32_bf16(Xk[kt][0], Y0b_, s_, 0, 0, 0); s_ = __builtin_amdgcn_mfma_f32_16x16x32_bf16(Xk[kt][1], Y1b_, s_, 0, 0, 0); sacc[kt][v2 + 1] = s_; } \
                __builtin_amdgcn_sched_barrier(0); \
                if (v2 + 3 < 4) { Y0b_ = ldfrag(VS + ((v2 + 3) * 16 + fr) * TPB + (8 * fq) * 2); Y1b_ = ldfrag(VS + ((v2 + 3) * 16 + fr) * TPB + (32 + 8 * fq) * 2); } } } \
        GI_LOADS_D(((n_) + 2 < 64 ? (n_) + 2 : 63), S); \
        __syncthreads(); \
        _Pragma("unroll") for (int kt = 0; kt < 2; ++kt) _Pragma("unroll") for (int v2 = 0; v2 < 4; ++v2) { v2u w; w.x = pk2(sacc[kt][v2][0], sacc[kt][v2][1]); w.y = pk2(sacc[kt][v2][2], sacc[kt][v2][3]); \
                *(LAS v2u*)(ST + (v2 * 16 + fr) * QPB + (32 * wid + 16 * kt + 4 * fq) * 2) = w; } } while (0)
    GI_LOADS(0, A); GI_LOADS(1, B);
#pragma unroll 1
    for (int n = 0; n < 64; n += 2) { GI_STEP(n, A); GI_STEP(n + 1, B); }
#undef GI_LOADS
#undef GI_LOADS_T
#undef GI_LOADS_D
#undef GI_LOADS_O
#undef GI_STEP
    __syncthreads();
}

__device__ __forceinline__ void phase_post(CArgs& a, int l, int gw, int NGW, int lane) {
    const bf16* P = (const bf16*)(a.ws + WS_P); const bf16* OG = (const bf16*)(a.ws + WS_T1); const bf16* OB = (const bf16*)(a.ws + WS_OB);
    bf16* OA = (bf16*)(a.ws + WS_OA); bf16* OBF = (bf16*)(a.ws + WS_OA) + DMOD;
    const float* dl = a.in[7] + (size_t)l * 256;
    const float s1 = wave_sum(dl[lane] * dl[64 + lane], lane), s2 = wave_sum(dl[128 + lane] * dl[192 + lane], lane);
    const float lam_init = 0.8f - 0.6f * expf(-0.3f * (float)l);
    const float lam = expf(s1) - expf(s2) + lam_init;
    const float oml = 1.0f - lam_init;
    const f32x4* gg = (const f32x4*)(a.in[6] + (size_t)l * 512 + lane * 8);
    const f32x4 gg0 = gg[0], gg1 = gg[1];
    const int hd = lane >> 2, sub = lane & 3;
    for (int row = gw; row < TOK; row += NGW) {
#pragma unroll
        for (int h = 0; h < 4; ++h) {
            const v4u ov_ = *(const v4u*)(OG + (size_t)row * DMOD + h * 512 + lane * 8);
            const f32x4 o0 = (f32x4){blo(ov_.x), bhi(ov_.x), blo(ov_.y), bhi(ov_.y)}, o1 = (f32x4){blo(ov_.z), bhi(ov_.z), blo(ov_.w), bhi(ov_.w)};
            const float ss = wave_sum((o0.x * o0.x + o0.y * o0.y) + (o0.z * o0.z + o0.w * o0.w) + (o1.x * o1.x + o1.y * o1.y) + (o1.z * o1.z + o1.w * o1.w), lane);
            const float rs = 1.0f / sqrtf(ss * (1.0f / 512.0f) + EPSN);
            const v4u ag = *(const v4u*)(P + (size_t)row * NPP + C_AG + h * 512 + lane * 8);
            v4u w;
            w.x = pk2(o0.x * rs * gg0.x * siluf(blo(ag.x)), o0.y * rs * gg0.y * siluf(bhi(ag.x)));
            w.y = pk2(o0.z * rs * gg0.z * siluf(blo(ag.y)), o0.w * rs * gg0.w * siluf(bhi(ag.y)));
            w.z = pk2(o1.x * rs * gg1.x * siluf(blo(ag.z)), o1.y * rs * gg1.y * siluf(bhi(ag.z)));
            w.w = pk2(o1.z * rs * gg1.z * siluf(blo(ag.w)), o1.w * rs * gg1.w * siluf(bhi(ag.w)));
            *(v4u*)(OA + (size_t)row * (2 * DMOD) + h * 512 + lane * 8) = w;
        }
        const v4u* p1 = (const v4u*)(OB + (size_t)row * 4096 + (2 * hd) * 128 + sub * 32);
        const v4u* p2 = (const v4u*)(OB + (size_t)row * 4096 + (2 * hd + 1) * 128 + sub * 32);
        float o[32]; float ss = 0.f;
#pragma unroll
        for (int c = 0; c < 4; ++c) { const v4u x = p1[c], y = p2[c];
            o[8 * c + 0] = blo(x.x) - lam * blo(y.x); o[8 * c + 1] = bhi(x.x) - lam * bhi(y.x);
            o[8 * c + 2] = blo(x.y) - lam * blo(y.y); o[8 * c + 3] = bhi(x.y) - lam * bhi(y.y);
            o[8 * c + 4] = blo(x.z) - lam * blo(y.z); o[8 * c + 5] = bhi(x.z) - lam * bhi(y.z);
            o[8 * c + 6] = blo(x.w) - lam * blo(y.w); o[8 * c + 7] = bhi(x.w) - lam * bhi(y.w); }
#pragma unroll
        for (int i = 0; i < 32; ++i) ss += o[i] * o[i];
        ss += shx(ss, 1, lane); ss += shx(ss, 2, lane);
        const float rs = oml / sqrtf(ss * (1.0f / 128.0f) + EPSN);
        const v4u* pg = (const v4u*)(P + (size_t)row * NPP + C_BG + hd * 128 + sub * 32);
        const f32x4* gn = (const f32x4*)(a.in[8] + (size_t)l * 128 + sub * 32);
        v4u* po = (v4u*)(OBF + (size_t)row * (2 * DMOD) + hd * 128 + sub * 32);
#pragma unroll
        for (int c = 0; c < 4; ++c) { const v4u g = pg[c]; const f32x4 n0 = gn[2 * c], n1 = gn[2 * c + 1]; v4u w;
            w.x = pk2(o[8 * c + 0] * rs * n0.x * siluf(blo(g.x)), o[8 * c + 1] * rs * n0.y * siluf(bhi(g.x)));
            w.y = pk2(o[8 * c + 2] * rs * n0.z * siluf(blo(g.y)), o[8 * c + 3] * rs * n0.w * siluf(bhi(g.y)));
            w.z = pk2(o[8 * c + 4] * rs * n1.x * siluf(blo(g.z)), o[8 * c + 5] * rs * n1.y * siluf(bhi(g.z)));
            w.w = pk2(o[8 * c + 6] * rs * n1.z * siluf(blo(g.w)), o[8 * c + 7] * rs * n1.w * siluf(bhi(g.w)));
            po[c] = w; }
    }
}

#ifdef PROBE_DOUBLE
constexpr int NPL = 7 + __builtin_popcount(PROBE_DOUBLE);
__device__ __forceinline__ int probe_k(int slot) { int s = 0; for (int k = 0; k < 7; ++k) { if (s == slot) return k; ++s; if ((PROBE_DOUBLE >> k) & 1) { if (s == slot) return k; ++s; } } return 6; }
#else
constexpr int NPL = 7;
#endif
constexpr int N_PHASES = 1 + NPL * DEPTH;
#ifndef PHMASK
#define PHMASK 0x1ff
#endif
__global__ void __launch_bounds__(NTHR, 2) mega_fwd(const Args args_) {
    extern __shared__ __attribute__((aligned(16))) unsigned char lds_raw[];
    LAS unsigned char* lds = (LAS unsigned char*)lds_raw;
    cg::grid_group grid = cg::this_grid();
    const int G = gridDim.x;
    const int wave0 = __builtin_amdgcn_readfirstlane((int)threadIdx.x >> 6);
    volatile LAS unsigned* MISC = (volatile LAS unsigned*)(lds + MISC_OFF);
    if (threadIdx.x < 32) MISC[threadIdx.x] = 0u;
    __syncthreads();
    { XcdBarrier b0 = xcd_barrier_post((unsigned*)(args_.ws) + CW_BAR, MISC + 8, (int)threadIdx.x); (void)b0; }
    grid.sync();
    const int ph_lo = args_.ph_lo;
    for (int ph = ph_lo; ; ++ph) {
        int lane_, wv_ = wave0, bx = blockIdx.x;
        asm volatile("v_mbcnt_lo_u32_b32 %0, -1, 0\n\tv_mbcnt_hi_u32_b32 %0, -1, %0" : "=v"(lane_));
        CArgs* ap = (CArgs*)__builtin_amdgcn_kernarg_segment_ptr();
        asm volatile("" : "+s"(wv_), "+s"(bx), "+s"(ap));
        CArgs& args = *ap;
#ifdef PROBE_SPIN
        if (bx == 0 && wv_ == 0 && lane_ == 0) {
            volatile LAS unsigned long long* T = (volatile LAS unsigned long long*)(lds + MISC_OFF + 80);
            const unsigned long long now = __builtin_amdgcn_s_memrealtime();
            if (T[2]) T[1] = T[1] + (now - T[0]);
            T[0] = now;
            const int kk_ = (ph == 0) ? 7 : (ph >= N_PHASES - 1) ? 8 : (ph - 1) % NPL;
            T[2] = (unsigned long long)((PROBE_SPIN >> kk_) & 1);
        }
#endif
        if (ph >= args.ph_hi) break;
        unsigned char* ws = args.ws;
#define PH_IDS() int ln_i; asm volatile("v_mbcnt_lo_u32_b32 %0, -1, 0\n\tv_mbcnt_hi_u32_b32 %0, -1, %0" : "=v"(ln_i)); const int tid = wv_ * 64 + ln_i, lane = ln_i, wave = wv_; const int gw = bx * NWAVES + wave, NGW = G * NWAVES; (void)tid; (void)lane; (void)gw; (void)NGW
        if (ph == 0) { PH_IDS(); if (PHMASK & 1) phase_weights(args, lds, gw, NGW, wave, lane);
            __syncthreads(); if (PHMASK & 2) phase_norm(args, lds, 0, gw, NGW, wave, lane); }
        else {
            const int l = (ph - 1) / NPL; int k = (ph - 1) % NPL;
#ifdef PROBE_DOUBLE
            k = probe_k(k);
#endif
            const bf16* WIN = (const bf16*)(ws + WS_WIN) + (size_t)l * NPP * DMOD;
            const bf16* WA = (const bf16*)(ws + WS_WABO) + (size_t)l * 3 * DMOD * DMOD; const bf16* WB = WA + (size_t)DMOD * DMOD; const bf16* WO = WB + (size_t)DMOD * DMOD;
            if (k == 0) { continue; }
            else if (k == 1) { PH_IDS(); if (PHMASK & 4) {
                if (l > 0) { alr_from_h(args, lds, l, gw, NGW, wave, lane); __syncthreads(); }
                pg8::Gemm g{(const bf16*)(ws + WS_H), WIN, TOK, NPP, DMOD}; pg8::StaticOrder S; S.init(TOK, NPP, G, bx);
                pg8::EpiProj E{(bf16*)(ws + WS_P)};
                pg8::gemm_phase<pg8::EpiProj, pg8::StaticOrder, true, true>(lds, g, S, E, tid); }
            } else if (k == 2) {
                PH_IDS();
                if (PHMASK & 8) for (int u = bx; u < 512; u += G) gla_intra_unit(args, l, lds, u >> 8, (u >> 2) & 63, u & 3, tid);
            } else if (k == 3) {
                PH_IDS();
                unsigned* qctr = (unsigned*)(args.ws) + CW_QUEUE + 64 * ph;
                volatile LAS unsigned* qw = (volatile LAS unsigned*)(lds + MISC_OFF) + 16;
#define QFETCH(dst) do { __syncthreads(); if (tid == 0) qw[0] = __hip_atomic_fetch_add(qctr, 1u, __ATOMIC_RELAXED, __HIP_MEMORY_SCOPE_AGENT); __syncthreads(); dst = __builtin_amdgcn_readfirstlane((int)qw[0]); } while (0)
                int idx; QFETCH(idx);
#ifdef PROBE_GLAT
                while (idx < 64) { unsigned long long t0_ = 0; if (idx == 0 && tid == 0) t0_ = __builtin_amdgcn_s_memrealtime();
                    gla_inter_unit(args, lds, idx >> 3, idx & 7, tid);
                    if (idx == 0 && tid == 0) atomicAdd((unsigned*)(args.ws) + 40960, (unsigned)(__builtin_amdgcn_s_memrealtime() - t0_));
                    QFETCH(idx); }
#else
                while (idx < 64) { gla_inter_unit(args, lds, idx >> 3, idx & 7, tid); QFETCH(idx); }
#endif
                int tid2 = tid; asm volatile("" : "+v"(tid2));
                while (idx < 64 + 256) {
                    const int aidx = idx - 64, r = aidx & 255, bh = r >> 2, qb = 15 - (4 * (aidx >> 8) + (r & 3));
                    const int b = bh >> 5, hh = bh & 31, h = hh >> 1, m = hh & 1;
                    const attn_body::bf16* Pp = (const attn_body::bf16*)(args.ws + WS_P);
                    attn_body::attn_unit<8>(b, qb, Pp + C_BQ + h * 128 + m * 64, Pp + C_BK + h * 128 + m * 64, Pp + C_BV + h * 128,
                                            (attn_body::bf16*)(args.ws + WS_OB) + (h * 2 + m) * 128, (char*)lds_raw, tid2);
                    __syncthreads(); if (tid2 == 0) qw[0] = __hip_atomic_fetch_add(qctr, 1u, __ATOMIC_RELAXED, __HIP_MEMORY_SCOPE_AGENT); __syncthreads(); idx = __builtin_amdgcn_readfirstlane((int)qw[0]);
                }
                while (idx < 64 + 256 + CV_UNITS) { if (l + 1 < DEPTH) convert_unit(args, lds, l + 1, idx - 64 - 256, wave, lane); QFETCH(idx); }
                int tid3 = tid; asm volatile("" : "+v"(tid3));
                while (idx < 64 + CV_UNITS + 1024) {
                    const int aidx = idx - 64 - CV_UNITS, r = aidx & 255, bh = r >> 2, qb = 15 - (4 * (aidx >> 8) + (r & 3));
                    const int b = bh >> 5, hh = bh & 31, h = hh >> 1, m = hh & 1;
                    const attn_body::bf16* Pp = (const attn_body::bf16*)(args.ws + WS_P);
                    attn_body::attn_unit<8>(b, qb, Pp + C_BQ + h * 128 + m * 64, Pp + C_BK + h * 128 + m * 64, Pp + C_BV + h * 128,
                                            (attn_body::bf16*)(args.ws + WS_OB) + (h * 2 + m) * 128, (char*)lds_raw, tid3);
                    __syncthreads(); if (tid3 == 0) qw[0] = __hip_atomic_fetch_add(qctr, 1u, __ATOMIC_RELAXED, __HIP_MEMORY_SCOPE_AGENT); __syncthreads(); idx = __builtin_amdgcn_readfirstlane((int)qw[0]);
                }
#undef QFETCH
            } else if (k == 4) { PH_IDS(); if (PHMASK & 64) phase_post(args, l, gw, NGW, lane); }
            else if (k == 5) { PH_IDS(); if (PHMASK & 128) {
                pg8::Gemm g{(const bf16*)(ws + WS_OA), WA, TOK, DMOD, 2 * DMOD}; pg8::StaticOrder S; S.init(TOK, DMOD, G, bx);
                pg8::EpiMerge E{(const bf16*)(ws + WS_P), (bf16*)(ws + WS_MG)};
                pg8::gemm_phase<pg8::EpiMerge, pg8::StaticOrder, true, true>(lds, g, S, E, tid); }
            } else if (PHMASK & 256) {
                PH_IDS();
                pg8::Gemm g{(const bf16*)(ws + WS_MG), WO, TOK, DMOD, DMOD}; pg8::StaticOrder S; S.init(TOK, DMOD, G, bx);
                pg8::Unit u0; S.next(0, u0);
                unsigned* xc = (unsigned*)(ws) + CW_XCNT + ((l * 2) * 32 + u0.pm) * 64;
                pg8::RowStats st1{(float*)(ws + WS_PS), xc}, st2{(float*)(ws + WS_PS) + (size_t)TOK * 8, xc + 32 * 64};
                const float* gpo = args.in[2] + (size_t)l * DMOD; const float* gpr = args.in[1] + (size_t)((l + 1 < DEPTH) ? l + 1 : l) * DMOD;
                void* xb = (void*)(ws + WS_OUT);
                if (l == 0) { pg8::EpiOutFusedT<false, true> E{(const void*)args.in[0], xb, (bf16*)(ws + WS_H), gpo, gpr, st1, st2, 0};
                    pg8::gemm_phase<pg8::EpiOutFusedT<false, true>, pg8::StaticOrder, false, true>(lds, g, S, E, tid); }
                else if (l + 1 < DEPTH) { pg8::EpiOutFusedT<true, true> E{(const void*)xb, xb, (bf16*)(ws + WS_H), gpo, gpr, st1, st2, 0};
                    pg8::gemm_phase<pg8::EpiOutFusedT<true, true>, pg8::StaticOrder, false, true>(lds, g, S, E, tid); }
                else { pg8::EpiOutFusedT<true, false> E{(const void*)xb, (void*)args.out, (bf16*)(ws + WS_H), gpo, gpr, st1, st2, 1};
                    pg8::gemm_phase<pg8::EpiOutFusedT<true, false>, pg8::StaticOrder, false, true>(lds, g, S, E, tid); }
            }
        }
        { int l2_; asm volatile("v_mbcnt_lo_u32_b32 %0, -1, 0\n\tv_mbcnt_hi_u32_b32 %0, -1, %0" : "=v"(l2_));
          CArgs* ap2 = (CArgs*)__builtin_amdgcn_kernarg_segment_ptr(); asm volatile("" : "+s"(ap2));
          if (ph + 1 < ap2->ph_hi) { XcdBarrier b; b.bar = (unsigned*)(ap2->ws) + CW_BAR; b.x = xb_xcc_id(); b.st = (volatile LAS unsigned*)(lds + MISC_OFF) + 8; xcd_barrier(b, wave0 * 64 + l2_); } }
    }
#ifdef PROBE_GLAT
    { int ln_; asm volatile("v_mbcnt_lo_u32_b32 %0, -1, 0\n\tv_mbcnt_hi_u32_b32 %0, -1, %0" : "=v"(ln_));
      if (blockIdx.x == 0 && wave0 == 0 && ln_ == 0) { const unsigned w = __hip_atomic_load((unsigned*)(args_.ws) + 40960, __ATOMIC_RELAXED, __HIP_MEMORY_SCOPE_AGENT);
        const unsigned long long t0 = __builtin_amdgcn_s_memrealtime(); while (__builtin_amdgcn_s_memrealtime() - t0 < (unsigned long long)w) __builtin_amdgcn_s_sleep(32); } }
#endif
#ifdef PROBE_SPIN
    int ln_; asm volatile("v_mbcnt_lo_u32_b32 %0, -1, 0\n\tv_mbcnt_hi_u32_b32 %0, -1, %0" : "=v"(ln_));
    if (blockIdx.x == 0 && wave0 == 0 && ln_ == 0) {
        volatile LAS unsigned long long* T = (volatile LAS unsigned long long*)(lds + MISC_OFF + 80);
        const unsigned long long t0 = __builtin_amdgcn_s_memrealtime(), w = T[1];
        while (__builtin_amdgcn_s_memrealtime() - t0 < w) __builtin_amdgcn_s_sleep(32);
    }
#endif
}

extern "C" void kernel_launch(void* const* d_in, const int* in_sizes, int n_in, void* d_out, int out_size, void* d_ws, size_t ws_size, hipStream_t stream) {
    static int grid = 0;
    if (grid == 0) {
        if (n_in != 12 || in_sizes[0] != TOK * DMOD || out_size != TOK * DMOD || ws_size < WS_END) { fprintf(stderr, "kernel_launch: unexpected shapes (n_in %d, in0 %d, out %d, ws %zu)\n", n_in, n_in > 0 ? in_sizes[0] : -1, out_size, ws_size); grid = -1; return; }
        int dev = 0, cus = 0, per_cu = 0;
        if (hipGetDevice(&dev) != hipSuccess || hipDeviceGetAttribute(&cus, hipDeviceAttributeMultiprocessorCount, dev) != hipSuccess) { grid = -1; return; }
        if (hipFuncSetAttribute((const void*)mega_fwd, hipFuncAttributeMaxDynamicSharedMemorySize, LDS_BYTES) != hipSuccess) { fprintf(stderr, "kernel_launch: hipFuncSetAttribute failed\n"); grid = -1; return; }
        if (hipOccupancyMaxActiveBlocksPerMultiprocessor(&per_cu, (const void*)mega_fwd, NTHR, LDS_BYTES) != hipSuccess || per_cu < 1) { fprintf(stderr, "kernel_launch: occupancy query says %d\n", per_cu); per_cu = 1; }
        (void)hipGetLastError();
        grid = cus;
        if (grid != 256) { fprintf(stderr, "kernel_launch: built for a 256-CU device (row striping of the thin phases), found %d CUs; nothing launched\n", grid); grid = -1; return; }
    }
    if (grid < 0) return;
    if (hipMemsetAsync(d_ws, 0, CTL_ZERO_BYTES, stream) != hipSuccess) { fprintf(stderr, "kernel_launch: memset of the control words failed\n"); return; }
    Args a{};
    for (int i = 0; i < 12; ++i) a.in[i] = (const float*)d_in[i];
    a.out = (float*)d_out; a.ws = (unsigned char*)d_ws; a.ph_lo = 0; a.ph_hi = N_PHASES;
    void* kargs[] = {&a};
    hipError_t e = hipLaunchCooperativeKernel((const void*)mega_fwd, dim3(grid), dim3(NTHR), kargs, LDS_BYTES, stream);
    if (e != hipSuccess) fprintf(stderr, "kernel_launch: cooperative launch failed: %s (grid %d)\n", hipGetErrorString(e), grid);
}
```
